# Optimizing an MI355X kernel written in HIP

```python
import jax, jax.numpy as jnp
from jax import lax
import numpy as np

D_MODEL = 2048
BATCH = 4
SEQ = 4096
DEPTH = 4

N_EVEN = (DEPTH + 1) // 2
N_ODD = DEPTH // 2
EPS = 1e-6
D_FF = 4 * D_MODEL
GROUP_DIM = 128
D_A = D_MODEL // 2
D_B = D_MODEL - D_A
N_A_GROUPS = D_A // GROUP_DIM
CHUNK = 128
CONV_WIDTH = 31
D_AB_IN = 2 * D_A + 2 * D_B
N_HEADS = 16
Q_RANK = 512
KV_RANK = 512
NOPE_DIM = 128
ROPE_DIM = 64
V_DIM = 128
QK_DIM = NOPE_DIM + ROPE_DIM
D_MLA_IN = Q_RANK + KV_RANK + ROPE_DIM
ROPE_THETA = 10000.0
Q_BLOCK = 128
ATTN_SCALE = QK_DIM ** -0.5

kernel_name = "hybrid_sgu_conv_mla_adaln_trunk"


def _rms(x, g):
    xf = x.astype(jnp.float32)
    y = xf * lax.rsqrt(jnp.mean(xf * xf, axis=-1, keepdims=True) + EPS)
    return (y * g.astype(jnp.float32)).astype(x.dtype)


def _layernorm(x, g, b):
    xf = x.astype(jnp.float32)
    mu = jnp.mean(xf, axis=-1, keepdims=True)
    var = jnp.mean(jnp.square(xf - mu), axis=-1, keepdims=True)
    y = (xf - mu) * lax.rsqrt(var + EPS)
    return (y * g.astype(jnp.float32) + b.astype(jnp.float32)).astype(x.dtype)


def _modulate(h, shift, scale):
    return h * (1 + scale[:, None, :]) + shift[:, None, :]


def _spatial_gating(u, v, v_norm_g, w_s, b_s):
    bsz, s, _ = u.shape
    shp = (bsz, s // CHUNK, CHUNK, N_A_GROUPS, GROUP_DIM)
    v = _rms(v.reshape(shp), v_norm_g)
    mask = jnp.tril(jnp.ones((CHUNK, CHUNK), dtype=w_s.dtype))
    mixed = jnp.einsum('gts,bnsgd->bntgd', w_s * mask, v) + b_s.T[None, None, :, :, None]
    return (u.reshape(shp) * mixed).reshape(bsz, s, D_A)


def _conformer_conv(a, g, conv_w, conv_b, ln_g, ln_b):
    y = a * jax.nn.sigmoid(g)
    y = lax.conv_general_dilated(y, conv_w[:, None, :], window_strides=(1,),
                                 padding=[(CONV_WIDTH - 1, 0)],
                                 dimension_numbers=('NWC', 'WIO', 'NWC'),
                                 feature_group_count=D_B) + conv_b
    return jax.nn.silu(_layernorm(y, ln_g, ln_b))


def _even_mixer(h, w_in, sgu_norm_g, sgu_w, sgu_b, conv_w, conv_b, ln_g, ln_b, w_out):
    proj = h @ w_in
    u, v, a, g = jnp.split(proj, [D_A, 2 * D_A, 2 * D_A + D_B], axis=-1)
    out_a = _spatial_gating(jax.nn.gelu(u), jax.nn.gelu(v), sgu_norm_g, sgu_w, sgu_b)
    out_b = _conformer_conv(a, g, conv_w, conv_b, ln_g, ln_b)
    return jnp.concatenate([out_a, out_b], axis=-1) @ w_out


def _rope_tables(s):
    pos = jnp.arange(s, dtype=jnp.float32)
    inv = ROPE_THETA ** (-jnp.arange(0, ROPE_DIM, 2, dtype=jnp.float32) / ROPE_DIM)
    ang = pos[:, None] * inv[None, :]
    return jnp.cos(ang), jnp.sin(ang)


def _apply_rope(x, cos, sin):
    xf = x.astype(jnp.float32)
    x1, x2 = jnp.split(xf, 2, axis=-1)
    return jnp.concatenate([x1 * cos - x2 * sin, x1 * sin + x2 * cos], axis=-1).astype(x.dtype)


def _segment_head_norm(t, g):
    return jnp.concatenate([_rms(t[..., :NOPE_DIM], g[:NOPE_DIM]),
                            _rms(t[..., NOPE_DIM:], g[NOPE_DIM:])], axis=-1)


def _block_causal_attention(q_nope, q_rope, k_nope, k_rope, v):
    s = q_nope.shape[1]
    outs = []
    for i in range(s // Q_BLOCK):
        q0, q1 = i * Q_BLOCK, (i + 1) * Q_BLOCK
        sc = (jnp.einsum('bqhd,bkhd->bhqk', q_nope[:, q0:q1], k_nope[:, :q1])
              + jnp.einsum('bqhr,bkr->bhqk', q_rope[:, q0:q1], k_rope[:, :q1]))
        sc = sc.astype(jnp.float32) * ATTN_SCALE
        qi = q0 + jnp.arange(Q_BLOCK)
        ki = jnp.arange(q1)
        sc = jnp.where(ki[None, :] <= qi[:, None], sc, -jnp.inf)
        p = jax.nn.softmax(sc, axis=-1).astype(v.dtype)
        outs.append(jnp.einsum('bhqk,bkhd->bqhd', p, v[:, :q1]))
    return jnp.concatenate(outs, axis=1)


def _mla_mixer(h, w_in, q_norm_g, kv_norm_g, w_uq, w_ukv, q_head_g, k_head_g, w_out):
    bsz, s, _ = h.shape
    proj = h @ w_in
    c_q, c_kv, k_rope = jnp.split(proj, [Q_RANK, Q_RANK + KV_RANK], axis=-1)
    q = (_rms(c_q, q_norm_g) @ w_uq).reshape(bsz, s, N_HEADS, QK_DIM)
    kv = (_rms(c_kv, kv_norm_g) @ w_ukv).reshape(bsz, s, N_HEADS, NOPE_DIM + V_DIM)
    k_nope, v = jnp.split(kv, [NOPE_DIM], axis=-1)
    q = _segment_head_norm(q, q_head_g)
    k_nope = _rms(k_nope, k_head_g[:NOPE_DIM])
    k_rope = _rms(k_rope, k_head_g[NOPE_DIM:])
    cos, sin = _rope_tables(s)
    q_rope = _apply_rope(q[..., NOPE_DIM:], cos[:, None, :], sin[:, None, :])
    k_rope = _apply_rope(k_rope, cos, sin)
    o = _block_causal_attention(q[..., :NOPE_DIM], q_rope, k_nope, k_rope, v)
    return o.reshape(bsz, s, N_HEADS * V_DIM) @ w_out


def setup_inputs(seed: int = 0) -> dict:
    key = jax.random.key(seed)
    ks = jax.random.split(key, 32)
    f = jnp.float32
    nrm = lambda k, shp, sc: jax.random.normal(k, shp, f) * sc
    d = D_MODEL
    return {
        "x": nrm(ks[0], (BATCH, SEQ, d), 1.0),
        "c": nrm(ks[1], (BATCH, d), 1.0),
        "norm1_g": 1.0 + nrm(ks[2], (DEPTH, d), 0.02),
        "norm2_g": 1.0 + nrm(ks[3], (DEPTH, d), 0.02),
        "ada_w": nrm(ks[4], (DEPTH, d, 6 * d), 0.5 * d ** -0.5),
        "ada_b": nrm(ks[5], (DEPTH, 6 * d), 0.01),
        "mlp_w1": nrm(ks[6], (DEPTH, d, D_FF), d ** -0.5),
        "mlp_w2": nrm(ks[7], (DEPTH, D_FF, d), D_FF ** -0.5),
        "ab_w_in": nrm(ks[8], (N_EVEN, d, D_AB_IN), d ** -0.5),
        "sgu_norm_g": 1.0 + nrm(ks[9], (N_EVEN, N_A_GROUPS, GROUP_DIM), 0.02),
        "sgu_w": nrm(ks[10], (N_EVEN, N_A_GROUPS, CHUNK, CHUNK), CHUNK ** -0.5),
        "sgu_b": 1.0 + nrm(ks[11], (N_EVEN, N_A_GROUPS, CHUNK), 0.02),
        "conv_w": nrm(ks[12], (N_EVEN, CONV_WIDTH, D_B), CONV_WIDTH ** -0.5),
        "conv_b": nrm(ks[13], (N_EVEN, D_B), 0.01),
        "conv_ln_g": 1.0 + nrm(ks[14], (N_EVEN, D_B), 0.02),
        "conv_ln_b": nrm(ks[15], (N_EVEN, D_B), 0.01),
        "ab_w_out": nrm(ks[16], (N_EVEN, D_A + D_B, d), (D_A + D_B) ** -0.5),
        "mla_w_in": nrm(ks[17], (N_ODD, d, D_MLA_IN), d ** -0.5),
        "mla_q_norm_g": 1.0 + nrm(ks[18], (N_ODD, Q_RANK), 0.02),
        "mla_kv_norm_g": 1.0 + nrm(ks[19], (N_ODD, KV_RANK), 0.02),
        "mla_w_uq": nrm(ks[20], (N_ODD, Q_RANK, N_HEADS * QK_DIM), Q_RANK ** -0.5),
        "mla_w_ukv": nrm(ks[21], (N_ODD, KV_RANK, N_HEADS * (NOPE_DIM + V_DIM)), KV_RANK ** -0.5),
        "mla_q_head_g": 1.0 + nrm(ks[22], (N_ODD, QK_DIM), 0.02),
        "mla_k_head_g": 1.0 + nrm(ks[23], (N_ODD, QK_DIM), 0.02),
        "mla_w_out": nrm(ks[24], (N_ODD, N_HEADS * V_DIM, d), (N_HEADS * V_DIM) ** -0.5),
    }


def reference(x, c, norm1_g, norm2_g, ada_w, ada_b, mlp_w1, mlp_w2,
              ab_w_in, sgu_norm_g, sgu_w, sgu_b, conv_w, conv_b, conv_ln_g, conv_ln_b, ab_w_out,
              mla_w_in, mla_q_norm_g, mla_kv_norm_g, mla_w_uq, mla_w_ukv,
              mla_q_head_g, mla_k_head_g, mla_w_out):
    c_act = jax.nn.silu(c.astype(x.dtype))
    for l in range(DEPTH):
        mod = c_act @ ada_w[l] + ada_b[l]
        shift1, scale1, gate1, shift2, scale2, gate2 = jnp.split(mod, 6, axis=-1)
        h = _modulate(_rms(x, norm1_g[l]), shift1, scale1)
        if l % 2 == 0:
            e = l // 2
            mix = _even_mixer(h, ab_w_in[e], sgu_norm_g[e], sgu_w[e], sgu_b[e], conv_w[e],
                              conv_b[e], conv_ln_g[e], conv_ln_b[e], ab_w_out[e])
        else:
            o = l // 2
            mix = _mla_mixer(h, mla_w_in[o], mla_q_norm_g[o], mla_kv_norm_g[o], mla_w_uq[o],
                             mla_w_ukv[o], mla_q_head_g[o], mla_k_head_g[o], mla_w_out[o])
        x = x + gate1[:, None, :] * mix
        h = _modulate(_rms(x, norm2_g[l]), shift2, scale2)
        x = x + gate2[:, None, :] * (jnp.square(jax.nn.relu(h @ mlp_w1[l])) @ mlp_w2[l])
    return x
```

```cpp
#include <hip/hip_runtime.h>
#include <cstdio>
#include <cstdint>
#include <cstring>

#define GEMM_REPS 1
#ifndef MEGA
#define MEGA 1
#endif

constexpr int D = 2048, NB = 4, SEQ = 4096, M = NB * SEQ, DEPTH = 4, DFF = 8192;
constexpr int DA = 1024, NG = 8, GD = 128, CONVW = 31, DABIN = 4096;
constexpr int NH = 16, QR = 512, KVR = 512, NOPE = 128, ROPE = 64, VD = 128, QKD = 192, DMLAIN = 1088, DMLAINP = 1280;
constexpr float EPS = 1e-6f;
constexpr float QSCALE = 0.07216878364870322f * 1.4426950408889634f;

constexpr size_t MiB = 1u << 20;
constexpr size_t WS_CTL = 0, CTL_ZERO_BYTES = 2 * MiB;
constexpr size_t WS_MOD = 2 * MiB, WS_ROPE = 3 * MiB, WS_MODP = 4 * MiB;
constexpr size_t WS_WT = 32 * MiB;
constexpr size_t WT_ABIN = 0, WT_ABOUT = WT_ABIN + (size_t)2 * DABIN * D, WT_MLAIN = WT_ABOUT + (size_t)2 * D * D,
                 WT_UQ = WT_MLAIN + (size_t)2 * DMLAINP * D, WT_UKV = WT_UQ + (size_t)2 * NH * QKD * QR,
                 WT_MLAOUT = WT_UKV + (size_t)2 * 4096 * KVR, WT_W1 = WT_MLAOUT + (size_t)2 * D * D,
                 WT_W2 = WT_W1 + (size_t)DEPTH * DFF * D, WT_END = WT_W2 + (size_t)DEPTH * DFF * D;
static_assert(WS_WT + WT_END * 2 <= 384 * MiB, "weights fit");
constexpr size_t WS_X = 384 * MiB, WS_H = 512 * MiB, WS_HID = 576 * MiB;
constexpr size_t WS_U = 576 * MiB, WS_VN = 608 * MiB, WS_Y = 640 * MiB, WS_AB = 672 * MiB, WS_Z = 736 * MiB;
constexpr size_t WS_CQ = 576 * MiB, WS_CKV = 592 * MiB, WS_KR = 608 * MiB, WS_Q = 640 * MiB, WS_KN = 736 * MiB, WS_VT = 800 * MiB,
                 WS_V = 864 * MiB, WS_O = 928 * MiB, WS_MSQ = 612 * MiB;
constexpr size_t WS_RAW = 1024 * MiB, WS_END = 1280 * MiB;

constexpr int CW_BAR = 4096;

constexpr int LDS_BYTES = 147456;
constexpr int LDS_SPARE = 131072;
constexpr int LDS_MISC = LDS_SPARE + 12288;

#define LAS __attribute__((address_space(3)))
typedef unsigned short bf16;
typedef float f32x4 __attribute__((ext_vector_type(4)));
typedef float f32x2 __attribute__((ext_vector_type(2)));
typedef unsigned u32x4 __attribute__((ext_vector_type(4)));
typedef unsigned u32x2 __attribute__((ext_vector_type(2)));
typedef short bf16x8 __attribute__((ext_vector_type(8)));

__device__ __forceinline__ int tidx() { int t = threadIdx.x; asm volatile("" : "+v"(t)); return t; }
__device__ __forceinline__ unsigned f2bf(float f) { unsigned u = __builtin_bit_cast(unsigned, f); return (u + 0x7fffu + ((u >> 16) & 1u)) >> 16; }
__device__ __forceinline__ unsigned pk2(float lo, float hi) { return f2bf(lo) | (f2bf(hi) << 16); }
typedef __bf16 bf16x2_t __attribute__((ext_vector_type(2)));
__device__ __forceinline__ unsigned cvtpk(float lo, float hi) { f32x2 v = {lo, hi}; bf16x2_t b = __builtin_convertvector(v, bf16x2_t); return __builtin_bit_cast(unsigned, b); }
__device__ __forceinline__ float bf_lo(unsigned w) { return __builtin_bit_cast(float, w << 16); }
__device__ __forceinline__ float bf_hi(unsigned w) { return __builtin_bit_cast(float, w & 0xffff0000u); }
__device__ __forceinline__ float bf2f(bf16 b) { return __builtin_bit_cast(float, (unsigned)b << 16); }
__device__ __forceinline__ float wave_sum(float v) {
#pragma unroll
    for (int o = 1; o < 64; o <<= 1) v += __shfl_xor(v, o);
    return v;
}
__device__ __forceinline__ float wave_max(float v) {
#pragma unroll
    for (int o = 1; o < 64; o <<= 1) v = fmaxf(v, __shfl_xor(v, o));
    return v;
}
__device__ __forceinline__ float gelu_tanh(float x) {
    const float y = 0.7978845608028654f * (x + 0.044715f * x * x * x);
    return x / (1.f + __expf(-2.f * y));
}
__device__ __forceinline__ float sigmoidf_(float x) { return 1.f / (1.f + __expf(-x)); }

struct Params {
    const float *x, *c, *norm1_g, *norm2_g, *ada_w, *ada_b, *mlp_w1, *mlp_w2, *ab_w_in, *sgu_norm_g, *sgu_w, *sgu_b, *conv_w, *conv_b,
        *conv_ln_g, *conv_ln_b, *ab_w_out, *mla_w_in, *mla_q_norm_g, *mla_kv_norm_g, *mla_w_uq, *mla_w_ukv, *mla_q_head_g, *mla_k_head_g, *mla_w_out;
    float* out; unsigned char* ws;
};
typedef const __attribute__((address_space(4))) Params& CP;
typedef const __attribute__((address_space(4))) Params* CPP;
__device__ __forceinline__ CPP kparams() { CPP q = (CPP)__builtin_amdgcn_kernarg_segment_ptr(); asm volatile("" : "+s"(q)); return q; }
namespace pg8 {
#define PG8_LAS __attribute__((address_space(3)))
typedef unsigned short bf16_t;
typedef short bf16x8 __attribute__((ext_vector_type(8)));
typedef float f32x4 __attribute__((ext_vector_type(4)));
typedef unsigned u32x4 __attribute__((ext_vector_type(4)));
constexpr int BM = 256, BK = 64, HALF = 128, HTB = HALF * BK * 2  , STAGE_BYTES = 8 * HTB, NXCD = 8;

__host__ __device__ __forceinline__ int lds_byte(int r, int c) { const int st = (r >> 4) * 2 + (c >> 5), rr = r & 15, cc = c & 31, ob = rr * 64 + cc * 2; return st * 1024 + (ob ^ (((ob >> 9) & 1) << 5)); }
__host__ __device__ __forceinline__ void stage_rc(int b, int& R, int& C) { const int st = b / 1024, sb = b % 1024, swz = sb ^ (((sb >> 9) & 1) << 5); R = (st >> 1) * 16 + swz / 64; C = (st & 1) * 32 + (swz % 64) / 2; }
__host__ __device__ __forceinline__ int perm32(int rho) { const int n = rho >> 4, i = rho & 15; return 8 * (i >> 2) + 4 * n + (i & 3); }

struct Unit { int pm, pn; };
struct Gemm { const bf16_t* A; const bf16_t* Bt; int M, N, K; };

struct StaticOrder {
    int nM, nN, nwg, G, c, WGM;
    __host__ __device__ void init(int M, int N, int G_, int c_, int wgm = 4) { nM = M / BM; nN = N / BM; nwg = nM * nN; G = G_; c = c_; WGM = wgm; }
    __host__ __device__ bool next(int i, Unit& u) const {
        const long L = (long)i * G + c; if (L >= nwg) return false;
        int wgid = (int)L; { const int q = nwg / NXCD, r = nwg % NXCD, xcd = wgid % NXCD, off = wgid / NXCD; wgid = (xcd < r ? xcd * (q + 1) : r * (q + 1) + (xcd - r) * q) + off; }
        const int nig = WGM * nN, gid = wgid / nig, fm = gid * WGM, gsz = (nM - fm) < WGM ? (nM - fm) : WGM;
        u.pm = fm + ((wgid % nig) % gsz); u.pn = (wgid % nig) / gsz; return true;
    }
    __device__ __forceinline__ void a_ready(const Unit&) const {}
    __device__ __forceinline__ void done(const Unit&) const {}
};
__device__ __forceinline__ unsigned cvt_pk_bf16(float lo, float hi) { unsigned r; asm volatile("v_cvt_pk_bf16_f32 %0, %1, %2" : "=v"(r) : "v"(lo), "v"(hi)); return r; }

struct EpiF32 {
    static constexpr bool PERM = false, AFTER_DRAIN = false;
    float* C; int ldc;
    __device__ __forceinline__ void redirect(float*) {}
    __device__ __forceinline__ void operator()(f32x4 (&acc)[2][2][4][2], const Unit& u, int wr, int wc, int fr, int fq) const {
        const int row0 = u.pm * BM + wr * 64 + fr, col0 = u.pn * BM + wc * 32 + 4 * fq;
#pragma unroll
        for (int ai = 0; ai < 2; ++ai)
#pragma unroll
            for (int m = 0; m < 4; ++m) { float* rowp = C + (size_t)(row0 + ai * HALF + m * 16) * ldc + col0;
#pragma unroll
                for (int bj = 0; bj < 2; ++bj)
#pragma unroll
                    for (int n = 0; n < 2; ++n) *(f32x4*)(rowp + bj * HALF + n * 16) = acc[ai][bj][m][n]; }
    }
};
struct EpiRelu2 {
    static constexpr bool PERM = true, AFTER_DRAIN = false;
    bf16_t* O; int ldc;
    __device__ __forceinline__ void redirect(float*) {}
    __device__ __forceinline__ void operator()(f32x4 (&acc)[2][2][4][2], const Unit& u, int wr, int wc, int fr, int fq) const {
        const int row0 = u.pm * BM + wr * 64 + fr, col0 = u.pn * BM + wc * 32 + 8 * fq;
#pragma unroll
        for (int ai = 0; ai < 2; ++ai)
#pragma unroll
            for (int m = 0; m < 4; ++m) { bf16_t* rowp = O + (size_t)(row0 + ai * HALF + m * 16) * ldc + col0;
#pragma unroll
                for (int bj = 0; bj < 2; ++bj) { f32x4 v0 = acc[ai][bj][m][0], v1 = acc[ai][bj][m][1];
#pragma unroll
                    for (int j = 0; j < 4; ++j) { const float a = fmaxf(v0[j], 0.f), b = fmaxf(v1[j], 0.f); v0[j] = a * a; v1[j] = b * b; }
                    u32x4 w; w.x = cvt_pk_bf16(v0[0], v0[1]); w.y = cvt_pk_bf16(v0[2], v0[3]); w.z = cvt_pk_bf16(v1[0], v1[1]); w.w = cvt_pk_bf16(v1[2], v1[3]);
                    *(u32x4*)(rowp + bj * HALF) = w; } }
    }
};
struct EpiResid {
    static constexpr bool PERM = false, AFTER_DRAIN = false;
    const float* xold; float* xnew; const float* gate; int ldc; int gate_bstride; int rows_per_batch;
    __device__ __forceinline__ void redirect(float* s) { xnew = s; }
    __device__ __forceinline__ void operator()(f32x4 (&acc)[2][2][4][2], const Unit& u, int wr, int wc, int fr, int fq) const {
        const int row0 = u.pm * BM + wr * 64 + fr, col0 = u.pn * BM + wc * 32 + 4 * fq;
        const float* gp = gate + (size_t)((u.pm * BM) / rows_per_batch) * gate_bstride + col0;
        f32x4 gv[2][2];
#pragma unroll
        for (int bj = 0; bj < 2; ++bj)
#pragma unroll
            for (int n = 0; n < 2; ++n) gv[bj][n] = *(const f32x4*)(gp + bj * HALF + n * 16);
#pragma unroll
        for (int ai = 0; ai < 2; ++ai)
#pragma unroll
            for (int m = 0; m < 4; ++m) { const size_t off = (size_t)(row0 + ai * HALF + m * 16) * ldc + col0;
#pragma unroll
                for (int bj = 0; bj < 2; ++bj)
#pragma unroll
                    for (int n = 0; n < 2; ++n) { const f32x4 xo = *(const f32x4*)(xold + off + bj * HALF + n * 16);
                        *(f32x4*)(xnew + off + bj * HALF + n * 16) = xo + gv[bj][n] * acc[ai][bj][m][n]; } }
    }
};
template <bool IN_F32, bool OUT_F32> struct EpiResidB {
    static constexpr bool PERM = true, AFTER_DRAIN = false;
    const void* xold; void* xnew; const float* gate; int ldc; int gate_bstride; int rows_per_batch;
    __device__ __forceinline__ void redirect(float* s) { xnew = s; }
    __device__ __forceinline__ void operator()(f32x4 (&acc)[2][2][4][2], const Unit& u, int wr, int wc, int fr, int fq) const {
        const int row0 = u.pm * BM + wr * 64 + fr, col0 = u.pn * BM + wc * 32 + 8 * fq;
        const float* gp = gate + (size_t)((u.pm * BM) / rows_per_batch) * gate_bstride + col0;
        f32x4 gv[2][2];
#pragma unroll
        for (int bj = 0; bj < 2; ++bj)
#pragma unroll
            for (int n = 0; n < 2; ++n) gv[bj][n] = *(const f32x4*)(gp + bj * HALF + 4 * n);
        if constexpr (IN_F32) {
#pragma unroll
            for (int am = 0; am < 4; ++am) { const int ai = am >> 1, m0 = 2 * (am & 1); f32x4 xf[4][2][2];
#pragma unroll
                for (int m = m0; m < m0 + 2; ++m)
#pragma unroll
                    for (int bj = 0; bj < 2; ++bj) { const float* xp = (const float*)xold + (size_t)(row0 + ai * HALF + m * 16) * ldc + col0 + bj * HALF; xf[m][bj][0] = *(const f32x4*)xp; xf[m][bj][1] = *(const f32x4*)(xp + 4); }
#pragma unroll
                for (int m = m0; m < m0 + 2; ++m)
#pragma unroll
                    for (int bj = 0; bj < 2; ++bj) { const size_t off = (size_t)(row0 + ai * HALF + m * 16) * ldc + col0 + bj * HALF;
                        const f32x4 x0 = xf[m][bj][0] + gv[bj][0] * acc[ai][bj][m][0], x1 = xf[m][bj][1] + gv[bj][1] * acc[ai][bj][m][1];
                        if constexpr (OUT_F32) { float* op = (float*)xnew + off; *(f32x4*)op = x0; *(f32x4*)(op + 4) = x1; }
                        else { u32x4 w; w.x = cvt_pk_bf16(x0[0], x0[1]); w.y = cvt_pk_bf16(x0[2], x0[3]); w.z = cvt_pk_bf16(x1[0], x1[1]); w.w = cvt_pk_bf16(x1[2], x1[3]); *(u32x4*)((bf16_t*)xnew + off) = w; } } }
        } else {
#pragma unroll
            for (int ai = 0; ai < 2; ++ai) { u32x4 xw[4][2];
#pragma unroll
                for (int m = 0; m < 4; ++m)
#pragma unroll
                    for (int bj = 0; bj < 2; ++bj) xw[m][bj] = *(const u32x4*)((const bf16_t*)xold + (size_t)(row0 + ai * HALF + m * 16) * ldc + col0 + bj * HALF);
#pragma unroll
                for (int m = 0; m < 4; ++m)
#pragma unroll
                    for (int bj = 0; bj < 2; ++bj) { const size_t off = (size_t)(row0 + ai * HALF + m * 16) * ldc + col0 + bj * HALF; const u32x4 w = xw[m][bj];
                        f32x4 x0 = (f32x4){__builtin_bit_cast(float, w.x << 16), __builtin_bit_cast(float, w.x & 0xffff0000u), __builtin_bit_cast(float, w.y << 16), __builtin_bit_cast(float, w.y & 0xffff0000u)};
                        f32x4 x1 = (f32x4){__builtin_bit_cast(float, w.z << 16), __builtin_bit_cast(float, w.z & 0xffff0000u), __builtin_bit_cast(float, w.w << 16), __builtin_bit_cast(float, w.w & 0xffff0000u)};
                        x0 = x0 + gv[bj][0] * acc[ai][bj][m][0]; x1 = x1 + gv[bj][1] * acc[ai][bj][m][1];
                        if constexpr (OUT_F32) { float* op = (float*)xnew + off; *(f32x4*)op = x0; *(f32x4*)(op + 4) = x1; }
                        else { u32x4 wo; wo.x = cvt_pk_bf16(x0[0], x0[1]); wo.y = cvt_pk_bf16(x0[2], x0[3]); wo.z = cvt_pk_bf16(x1[0], x1[1]); wo.w = cvt_pk_bf16(x1[2], x1[3]); *(u32x4*)((bf16_t*)xnew + off) = wo; } } }
        }
    }
};
struct EpiBf16Plain {
    static constexpr bool PERM = true, AFTER_DRAIN = false;
    bf16_t* O; int ldc;
    __device__ __forceinline__ void redirect(float*) {}
    __device__ __forceinline__ void operator()(f32x4 (&acc)[2][2][4][2], const Unit& u, int wr, int wc, int fr, int fq) const {
        const int row0 = u.pm * BM + wr * 64 + fr, col0 = u.pn * BM + wc * 32 + 8 * fq;
#pragma unroll
        for (int ai = 0; ai < 2; ++ai)
#pragma unroll
            for (int m = 0; m < 4; ++m) { bf16_t* rowp = O + (size_t)(row0 + ai * HALF + m * 16) * ldc + col0;
#pragma unroll
                for (int bj = 0; bj < 2; ++bj) { const f32x4 v0 = acc[ai][bj][m][0], v1 = acc[ai][bj][m][1];
                    u32x4 w; w.x = cvt_pk_bf16(v0[0], v0[1]); w.y = cvt_pk_bf16(v0[2], v0[3]); w.z = cvt_pk_bf16(v1[0], v1[1]); w.w = cvt_pk_bf16(v1[2], v1[3]);
                    *(u32x4*)(rowp + bj * HALF) = w; } }
    }
};
__device__ __forceinline__ float msq_kv(const float* P, size_t row) { const f32x4 a = *(const f32x4*)(P + row * 16 + 8), b = *(const f32x4*)(P + row * 16 + 12); return (((a[0] + a[1]) + (a[2] + a[3])) + ((b[0] + b[1]) + (b[2] + b[3]))) * (1.0f / 512.0f); }
struct EpiKNorm {
    static constexpr bool PERM = true, AFTER_DRAIN = false;
    bf16_t* O; int ldc; const float* kg; const float* qg; PG8_LAS float* xch; const float* P;
    __device__ __forceinline__ void redirect(float*) {}
    __device__ __forceinline__ void operator()(f32x4 (&acc)[2][2][4][2], const Unit& u, int wr, int wc, int fr, int fq) const {
        const int row0 = u.pm * BM + wr * 64 + fr, col0 = u.pn * BM + wc * 32 + 8 * fq;
        PG8_LAS float* xw = xch + (wr * 16 * 16 + fr) * 4;
#pragma unroll
        for (int ai = 0; ai < 2; ++ai)
#pragma unroll
            for (int m = 0; m < 4; ++m)
#pragma unroll
                for (int bj = 0; bj < 2; ++bj) { const f32x4 v0 = acc[ai][bj][m][0], v1 = acc[ai][bj][m][1];
                    float ss = (v0[0] * v0[0] + v0[1] * v0[1]) + (v0[2] * v0[2] + v0[3] * v0[3]) + (v1[0] * v1[0] + v1[1] * v1[1]) + (v1[2] * v1[2] + v1[3] * v1[3]);
                    ss += __shfl_xor(ss, 16); ss += __shfl_xor(ss, 32);
                    if (fq == 0) xw[(((ai * 4 + m) * 2 + bj) * 16) * 4 + wc] = ss; }
        float epsr[2][4];
#pragma unroll
        for (int ai = 0; ai < 2; ++ai)
#pragma unroll
            for (int m = 0; m < 4; ++m) epsr[ai][m] = 1e-6f * (msq_kv(P, (size_t)(row0 + ai * HALF + m * 16)) + 1e-6f);
        asm volatile("s_waitcnt lgkmcnt(0)" ::: "memory"); __builtin_amdgcn_s_barrier(); asm volatile("" ::: "memory");
        const f32x4 g0 = *(const f32x4*)(kg + wc * 32 + 8 * fq) * *(const f32x4*)(qg + wc * 32 + 8 * fq), g1 = *(const f32x4*)(kg + wc * 32 + 8 * fq + 4) * *(const f32x4*)(qg + wc * 32 + 8 * fq + 4);
#pragma unroll
        for (int ai = 0; ai < 2; ++ai)
#pragma unroll
            for (int m = 0; m < 4; ++m) { bf16_t* rowp = O + (size_t)(row0 + ai * HALF + m * 16) * ldc + col0;
#pragma unroll
                for (int bj = 0; bj < 2; ++bj) { const f32x4 q4 = *(const PG8_LAS f32x4*)(xw + (((ai * 4 + m) * 2 + bj) * 16) * 4);
                    const float rk = __builtin_amdgcn_rsqf(((q4[0] + q4[1]) + (q4[2] + q4[3])) * (1.0f / 128.0f) + epsr[ai][m]);
                    const f32x4 v0 = acc[ai][bj][m][0] * rk * g0, v1 = acc[ai][bj][m][1] * rk * g1;
                    u32x4 w; w.x = cvt_pk_bf16(v0[0], v0[1]); w.y = cvt_pk_bf16(v0[2], v0[3]); w.z = cvt_pk_bf16(v1[0], v1[1]); w.w = cvt_pk_bf16(v1[2], v1[3]);
                    *(u32x4*)(rowp + bj * HALF) = w; } }
    }
};
__device__ __forceinline__ float gelu_t(float x) { const float y = x * (-2.302208198f - 0.10294324f * x * x); return x * __builtin_amdgcn_rcpf(1.f + __builtin_amdgcn_exp2f(y)); }
__device__ __forceinline__ float sigm_t(float g) { return __builtin_amdgcn_rcpf(1.f + __builtin_amdgcn_exp2f(-1.4426950408889634f * g)); }
struct EpiEvenIn {
    static constexpr bool PERM = true, AFTER_DRAIN = false;
    bf16_t *G, *Y;
    __device__ __forceinline__ void redirect(float*) {}
    __device__ __forceinline__ void operator()(f32x4 (&acc)[2][2][4][2], const Unit& u, int wr, int wc, int fr, int fq) const {
        const int row0 = u.pm * BM + wr * 64 + fr, tcol = wc * 32 + 8 * fq;
        if (u.pn < 8) {
#pragma unroll
            for (int ai = 0; ai < 2; ++ai)
#pragma unroll
                for (int m = 0; m < 4; ++m) { bf16_t* rowp = G + (size_t)(row0 + ai * HALF + m * 16) * 2048 + u.pn * BM + tcol;
#pragma unroll
                    for (int bj = 0; bj < 2; ++bj) { const f32x4 v0 = acc[ai][bj][m][0], v1 = acc[ai][bj][m][1];
                        u32x4 w; w.x = cvt_pk_bf16(gelu_t(v0[0]), gelu_t(v0[1])); w.y = cvt_pk_bf16(gelu_t(v0[2]), gelu_t(v0[3])); w.z = cvt_pk_bf16(gelu_t(v1[0]), gelu_t(v1[1])); w.w = cvt_pk_bf16(gelu_t(v1[2]), gelu_t(v1[3]));
                        *(u32x4*)(rowp + bj * HALF) = w; } }
        } else {
#pragma unroll
            for (int ai = 0; ai < 2; ++ai)
#pragma unroll
                for (int m = 0; m < 4; ++m) { bf16_t* rowp = Y + (size_t)(row0 + ai * HALF + m * 16) * 1024 + (u.pn - 8) * HALF + tcol;
                    f32x4 v0 = acc[ai][0][m][0], v1 = acc[ai][0][m][1]; const f32x4 g0 = acc[ai][1][m][0], g1 = acc[ai][1][m][1];
#pragma unroll
                    for (int j = 0; j < 4; ++j) { v0[j] = v0[j] * sigm_t(g0[j]); v1[j] = v1[j] * sigm_t(g1[j]); }
                    u32x4 w; w.x = cvt_pk_bf16(v0[0], v0[1]); w.y = cvt_pk_bf16(v0[2], v0[3]); w.z = cvt_pk_bf16(v1[0], v1[1]); w.w = cvt_pk_bf16(v1[2], v1[3]);
                    *(u32x4*)(rowp) = w; }
        }
    }
};
struct EpiBf16Split {
    static constexpr bool PERM = true, AFTER_DRAIN = false;
    bf16_t* O; int ldc; int split_cols; size_t split_stride;
    __device__ __forceinline__ void redirect(float*) {}
    __device__ __forceinline__ void operator()(f32x4 (&acc)[2][2][4][2], const Unit& u, int wr, int wc, int fr, int fq) const {
        const int row0 = u.pm * BM + wr * 64 + fr; int colt = u.pn * BM; const int t = colt / split_cols; colt -= t * split_cols;
        bf16_t* base = O + (size_t)t * split_stride + colt + wc * 32 + 8 * fq;
#pragma unroll
        for (int ai = 0; ai < 2; ++ai)
#pragma unroll
            for (int m = 0; m < 4; ++m) { bf16_t* rowp = base + (size_t)(row0 + ai * HALF + m * 16) * ldc;
#pragma unroll
                for (int bj = 0; bj < 2; ++bj) { const f32x4 v0 = acc[ai][bj][m][0], v1 = acc[ai][bj][m][1];
                    u32x4 w; w.x = cvt_pk_bf16(v0[0], v0[1]); w.y = cvt_pk_bf16(v0[2], v0[3]); w.z = cvt_pk_bf16(v1[0], v1[1]); w.w = cvt_pk_bf16(v1[2], v1[3]);
                    *(u32x4*)(rowp + bj * HALF) = w; } }
    }
};
struct EpiBf16SplitSsq {
    static constexpr bool PERM = true, AFTER_DRAIN = false;
    bf16_t* O; int ldc; int split_cols; size_t split_stride; float* P;
    __device__ __forceinline__ void redirect(float*) {}
    __device__ __forceinline__ void operator()(f32x4 (&acc)[2][2][4][2], const Unit& u, int wr, int wc, int fr, int fq) const {
        const int row0 = u.pm * BM + wr * 64 + fr; int colt = u.pn * BM; const int t = colt / split_cols; colt -= t * split_cols;
        bf16_t* base = O + (size_t)t * split_stride + colt + wc * 32 + 8 * fq;
#pragma unroll
        for (int ai = 0; ai < 2; ++ai)
#pragma unroll
            for (int m = 0; m < 4; ++m) { bf16_t* rowp = base + (size_t)(row0 + ai * HALF + m * 16) * ldc; float ss = 0.f;
#pragma unroll
                for (int bj = 0; bj < 2; ++bj) { const f32x4 v0 = acc[ai][bj][m][0], v1 = acc[ai][bj][m][1];
                    ss += (v0[0] * v0[0] + v0[1] * v0[1]) + (v0[2] * v0[2] + v0[3] * v0[3]) + (v1[0] * v1[0] + v1[1] * v1[1]) + (v1[2] * v1[2] + v1[3] * v1[3]);
                    u32x4 w; w.x = cvt_pk_bf16(v0[0], v0[1]); w.y = cvt_pk_bf16(v0[2], v0[3]); w.z = cvt_pk_bf16(v1[0], v1[1]); w.w = cvt_pk_bf16(v1[2], v1[3]);
                    *(u32x4*)(rowp + bj * HALF) = w; }
                ss += __shfl_xor(ss, 16); ss += __shfl_xor(ss, 32);
                if (fq == 0) P[(size_t)(row0 + ai * HALF + m * 16) * 16 + u.pn * 4 + wc] = ss; }
    }
};
struct EpiVtScale {
    static constexpr bool PERM = true, AFTER_DRAIN = false;
    bf16_t* O; int ldc; const float* P;
    __device__ __forceinline__ void redirect(float*) {}
    __device__ __forceinline__ void operator()(f32x4 (&acc)[2][2][4][2], const Unit& u, int wr, int wc, int fr, int fq) const {
        const int row0 = u.pm * BM + wr * 64 + fr, col0 = u.pn * BM + wc * 32 + 8 * fq;
        f32x4 sc[2][2];
#pragma unroll
        for (int bj = 0; bj < 2; ++bj)
#pragma unroll
            for (int j = 0; j < 8; ++j) sc[bj][j >> 2][j & 3] = __builtin_amdgcn_rsqf(msq_kv(P, (size_t)(col0 + bj * HALF + j)) + 1e-6f);
#pragma unroll
        for (int ai = 0; ai < 2; ++ai)
#pragma unroll
            for (int m = 0; m < 4; ++m) { bf16_t* rowp = O + (size_t)(row0 + ai * HALF + m * 16) * ldc + col0;
#pragma unroll
                for (int bj = 0; bj < 2; ++bj) { const f32x4 v0 = acc[ai][bj][m][0] * sc[bj][0], v1 = acc[ai][bj][m][1] * sc[bj][1];
                    u32x4 w; w.x = cvt_pk_bf16(v0[0], v0[1]); w.y = cvt_pk_bf16(v0[2], v0[3]); w.z = cvt_pk_bf16(v1[0], v1[1]); w.w = cvt_pk_bf16(v1[2], v1[3]);
                    *(u32x4*)(rowp + bj * HALF) = w; } }
    }
};
struct EpiFirst64 {
    static constexpr bool PERM = true, AFTER_DRAIN = false;
    bf16_t* O;
    __device__ __forceinline__ void redirect(float*) {}
    __device__ __forceinline__ void operator()(f32x4 (&acc)[2][2][4][2], const Unit& u, int wr, int wc, int fr, int fq) const {
        if (wc < 2) {
            const int row0 = u.pm * BM + wr * 64 + fr;
#pragma unroll
            for (int ai = 0; ai < 2; ++ai)
#pragma unroll
                for (int m = 0; m < 4; ++m) { const f32x4 v0 = acc[ai][0][m][0], v1 = acc[ai][0][m][1];
                    u32x4 w; w.x = cvt_pk_bf16(v0[0], v0[1]); w.y = cvt_pk_bf16(v0[2], v0[3]); w.z = cvt_pk_bf16(v1[0], v1[1]); w.w = cvt_pk_bf16(v1[2], v1[3]);
                    *(u32x4*)(O + (size_t)(row0 + ai * HALF + m * 16) * 64 + wc * 32 + 8 * fq) = w; }
        }
    }
};
template <class Epi, class Sched, bool ALIGN_EPI = false, bool SP2 = false>
__device__ __forceinline__ void gemm_phase(PG8_LAS unsigned char* lds, const Gemm g, const Sched& S, const Epi& E) {
    const int tid = tidx(), wid = __builtin_amdgcn_readfirstlane(tid >> 6), lane = tid & 63, wr = wid >> 2, wc = wid & 3, fr = lane & 15, fq = lane >> 4;
    const int K = g.K, nt = K / BK;
    unsigned voffA[2], voffB[2];
#pragma unroll
    for (int i = 0; i < 2; ++i) { int R, C; stage_rc(tid * 16 + i * 8192, R, C); const int Rb = Epi::PERM ? ((R & ~31) + perm32(R & 31)) : R;
        voffA[i] = (unsigned)(R * K + C) * 2u; voffB[i] = (unsigned)(Rb * K + C) * 2u; }
    const unsigned kstep = (unsigned)(BK * 2);
    const unsigned hstep = (unsigned)HALF * (unsigned)K * 2u;
    const unsigned tstep = 2u * hstep;
    const __amdgpu_buffer_rsrc_t rs_voffA = __builtin_amdgcn_make_buffer_rsrc((void*)g.A, (short)0, 0x7ffffff0, 0x00020000);
    const __amdgpu_buffer_rsrc_t rs_voffB = __builtin_amdgcn_make_buffer_rsrc((void*)g.Bt, (short)0, 0x7ffffff0, 0x00020000);
    const unsigned ldsw = (unsigned)wid * 1024u;
    const int aoff = lds_byte(wr * 64 + fr, fq * 8), boff = lds_byte(wc * 32 + fr, fq * 8);
#define PG8_SA(b, h) (((b) * 2 + (h)) * HTB)
#define PG8_SB(b, h) ((4 + (b) * 2 + (h)) * HTB)
#define PG8_STAGE(bufoff, gbase, voff) do { _Pragma("unroll") for (int _i = 0; _i < 2; ++_i) \
        __builtin_amdgcn_raw_ptr_buffer_load_lds(rs_##voff, (PG8_LAS void*)(lds + (bufoff) + ldsw + _i * 8192), 16, (voff)[_i], (gbase), 0, 0); } while (0)
#define PG8_LDA(dst, b, h) do { _Pragma("unroll") for (int m = 0; m < 4; ++m) _Pragma("unroll") for (int k = 0; k < 2; ++k) dst[m][k] = *(const PG8_LAS bf16x8*)(lds + PG8_SA(b, h) + aoff + m * 2048 + k * 1024); } while (0)
#define PG8_LDB(dst, b, h) do { _Pragma("unroll") for (int n = 0; n < 2; ++n) _Pragma("unroll") for (int k = 0; k < 2; ++k) dst[n][k] = *(const PG8_LAS bf16x8*)(lds + PG8_SB(b, h) + boff + n * 2048 + k * 1024); } while (0)
#define PG8_MMA(ai, bj, At, Bt) do { __builtin_amdgcn_s_setprio(1); _Pragma("unroll") for (int m = 0; m < 4; ++m) _Pragma("unroll") for (int n = 0; n < 2; ++n) _Pragma("unroll") for (int k = 0; k < 2; ++k) \
        acc[ai][bj][m][n] = __builtin_amdgcn_mfma_f32_16x16x32_bf16(Bt[n][k], At[m][k], acc[ai][bj][m][n], 0, 0, 0); __builtin_amdgcn_s_setprio(0); } while (0)
#define PG8_WAIT_V(n) asm volatile("s_waitcnt vmcnt(" #n ")" ::: "memory")
#define PG8_WAIT_L(n) asm volatile("s_waitcnt lgkmcnt(" #n ")" ::: "memory")
#define PG8_BAR __builtin_amdgcn_s_barrier()
#define PG8_SCHED __builtin_amdgcn_sched_barrier(0)
    Unit cur, nxt; int ui = 0;
    if (!S.next(0, cur)) return;
    f32x4 acc[2][2][4][2];
#pragma unroll
    for (int a = 0; a < 2; ++a)
#pragma unroll
        for (int b = 0; b < 2; ++b)
#pragma unroll
            for (int m = 0; m < 4; ++m)
#pragma unroll
                for (int n = 0; n < 2; ++n) acc[a][b][m][n] = (f32x4){0.f, 0.f, 0.f, 0.f};
    bf16x8 At[4][2], B0[2][2], B1[2][2];
    unsigned cA = (unsigned)cur.pm * tstep, cB = (unsigned)cur.pn * tstep;
    S.a_ready(cur);
    if constexpr (SP2) {
        PG8_STAGE(PG8_SB(0, 0), cB, voffB); PG8_STAGE(PG8_SB(0, 1), cB + hstep, voffB); PG8_STAGE(PG8_SA(0, 0), cA, voffA); PG8_STAGE(PG8_SA(0, 1), cA + hstep, voffA);
        if (wr == 1) PG8_BAR;
        PG8_WAIT_V(2); PG8_BAR;
        PG8_STAGE(PG8_SB(1, 0), cB + kstep, voffB); PG8_STAGE(PG8_SA(1, 0), cA + kstep, voffA); PG8_STAGE(PG8_SB(1, 1), cB + hstep + kstep, voffB);
        PG8_WAIT_V(6); PG8_BAR;
    } else {
        PG8_STAGE(PG8_SB(0, 0), cB, voffB); PG8_STAGE(PG8_SA(0, 0), cA, voffA); PG8_STAGE(PG8_SB(0, 1), cB + hstep, voffB); PG8_STAGE(PG8_SA(0, 1), cA + hstep, voffA);
        if (wr == 1) PG8_BAR;
        PG8_WAIT_V(4); PG8_BAR;
        PG8_STAGE(PG8_SB(1, 0), cB + kstep, voffB); PG8_STAGE(PG8_SA(1, 0), cA + kstep, voffA); PG8_STAGE(PG8_SB(1, 1), cB + hstep + kstep, voffB);
        PG8_WAIT_V(6); PG8_BAR;
    }
    for (;;) {
        const bool has_next = S.next(ui + 1, nxt);
        const unsigned nA = has_next ? (unsigned)nxt.pm * tstep : cA, nB = has_next ? (unsigned)nxt.pn * tstep : cB;
        for (int t = 0; t < nt; t += 2) {
            const bool last = (t == nt - 2);
            const unsigned a1 = cA + (unsigned)(t + 1) * kstep;
            const unsigned a2 = last ? nA : cA + (unsigned)(t + 2) * kstep, b2 = last ? nB : cB + (unsigned)(t + 2) * kstep;
            const unsigned a3 = a2 + kstep, b3 = b2 + kstep;
            if (last && has_next) S.a_ready(nxt);
            if constexpr (SP2) {
            PG8_LDB(B0, 0, 0); PG8_LDB(B1, 0, 1); PG8_SCHED; PG8_LDA(At, 0, 0); PG8_STAGE(PG8_SA(1, 1), a1 + hstep, voffA);
            PG8_WAIT_V(8); PG8_WAIT_L(0); PG8_BAR; PG8_MMA(0, 0, At, B0); PG8_MMA(0, 1, At, B1); PG8_BAR; PG8_SCHED;
            PG8_LDA(At, 0, 1); PG8_STAGE(PG8_SB(0, 0), b2, voffB); PG8_STAGE(PG8_SB(0, 1), b2 + hstep, voffB); PG8_STAGE(PG8_SA(0, 0), a2, voffA);
            PG8_WAIT_V(8); PG8_WAIT_L(0); PG8_BAR; PG8_MMA(1, 0, At, B0); PG8_MMA(1, 1, At, B1); PG8_BAR; PG8_SCHED;
            PG8_LDB(B0, 1, 0); PG8_LDB(B1, 1, 1); PG8_SCHED; PG8_LDA(At, 1, 0); PG8_STAGE(PG8_SA(0, 1), a2 + hstep, voffA);
            PG8_WAIT_V(8); PG8_WAIT_L(0); PG8_BAR; PG8_MMA(0, 0, At, B0); PG8_MMA(0, 1, At, B1); PG8_BAR; PG8_SCHED;
            PG8_LDA(At, 1, 1); PG8_STAGE(PG8_SB(1, 0), b3, voffB); PG8_STAGE(PG8_SB(1, 1), b3 + hstep, voffB); PG8_STAGE(PG8_SA(1, 0), a3, voffA);
            PG8_WAIT_V(8); PG8_WAIT_L(0); PG8_BAR; PG8_MMA(1, 0, At, B0); PG8_MMA(1, 1, At, B1); PG8_BAR; PG8_SCHED;
            } else {
            PG8_LDB(B0, 0, 0); PG8_SCHED; PG8_LDA(At, 0, 0); PG8_STAGE(PG8_SA(1, 1), a1 + hstep, voffA);
            PG8_WAIT_L(8); PG8_BAR; PG8_WAIT_L(0); PG8_MMA(0, 0, At, B0); PG8_BAR; PG8_SCHED;
            PG8_LDB(B1, 0, 1); PG8_STAGE(PG8_SB(0, 0), b2, voffB);
            PG8_BAR; PG8_WAIT_L(0); PG8_MMA(0, 1, At, B1); PG8_BAR;
            PG8_LDA(At, 0, 1); PG8_STAGE(PG8_SA(0, 0), a2, voffA);
            PG8_BAR; PG8_WAIT_L(0); PG8_MMA(1, 0, At, B0); PG8_BAR; PG8_SCHED;
            PG8_STAGE(PG8_SB(0, 1), b2 + hstep, voffB);
            PG8_WAIT_V(6); PG8_BAR; PG8_MMA(1, 1, At, B1); PG8_BAR;
            PG8_LDB(B0, 1, 0); PG8_SCHED; PG8_LDA(At, 1, 0); PG8_STAGE(PG8_SA(0, 1), a2 + hstep, voffA);
            PG8_WAIT_L(8); PG8_BAR; PG8_WAIT_L(0); PG8_MMA(0, 0, At, B0); PG8_BAR; PG8_SCHED;
            PG8_LDB(B1, 1, 1); PG8_STAGE(PG8_SB(1, 0), b3, voffB);
            PG8_BAR; PG8_WAIT_L(0); PG8_MMA(0, 1, At, B1); PG8_BAR;
            PG8_LDA(At, 1, 1); PG8_STAGE(PG8_SA(1, 0), a3, voffA);
            PG8_BAR; PG8_WAIT_L(0); PG8_MMA(1, 0, At, B0); PG8_BAR; PG8_SCHED;
            PG8_STAGE(PG8_SB(1, 1), b3 + hstep, voffB);
            PG8_WAIT_V(6); PG8_BAR; PG8_MMA(1, 1, At, B1); PG8_BAR;
            }
        }
        if constexpr (ALIGN_EPI) { if (wr == 0) PG8_BAR; }
        if constexpr (!Epi::AFTER_DRAIN) { E(acc, cur, wr, wc, fr, fq); S.done(cur); }
        if (!has_next) break;
#pragma unroll
        for (int a = 0; a < 2; ++a)
#pragma unroll
            for (int b = 0; b < 2; ++b)
#pragma unroll
                for (int m = 0; m < 4; ++m)
#pragma unroll
                    for (int n = 0; n < 2; ++n) acc[a][b][m][n] = (f32x4){0.f, 0.f, 0.f, 0.f};
        cur = nxt; cA = nA; cB = nB; ++ui;
        if constexpr (ALIGN_EPI) { if (wr == 1) PG8_BAR; }
    }
    PG8_WAIT_V(0);
    if constexpr (!ALIGN_EPI) { if (wr == 0) PG8_BAR; }
    PG8_BAR;
    if constexpr (Epi::AFTER_DRAIN) { E.fused(acc, cur, wr, wc, fr, fq, lds, wid, lane); S.done(cur); }
#undef PG8_SA
#undef PG8_SB
#undef PG8_STAGE
#undef PG8_LDA
#undef PG8_LDB
#undef PG8_MMA
#undef PG8_WAIT_V
#undef PG8_WAIT_L
#undef PG8_BAR
#undef PG8_SCHED
}
}
#define XB_TMO      128
#define XB_XCNT(j)  (256  + 64 * (j))
#define XB_XSUB(j)  (1280 + 64 * (j))
#define XB_XGEN(j)  (2304 + 64 * (j))
#define XB_TOP      3328
#define XB_TOPGEN   3392
#define XCD_BAR_WORDS 3456
#define XB_SPIN_CAP (1u << 18)

__device__ __forceinline__ unsigned xb_ld(unsigned* p)              { return __hip_atomic_load(p, __ATOMIC_RELAXED, __HIP_MEMORY_SCOPE_AGENT); }
__device__ __forceinline__ unsigned xb_add(unsigned* p, unsigned v) { return __hip_atomic_fetch_add(p, v, __ATOMIC_RELAXED, __HIP_MEMORY_SCOPE_AGENT); }
__device__ __forceinline__ unsigned xb_xcc_id() { return (unsigned)__builtin_amdgcn_s_getreg((3 << 11) | 20) & 0xFu; }
#define XB_SPIN(cond, bar) do { unsigned _sp = 0; while (cond) { __builtin_amdgcn_s_sleep(1); \
    if ((++_sp & 255u) == 0u) { if (xb_ld(&(bar)[XB_TMO])) break; if (_sp > XB_SPIN_CAP) { atomicAdd(&(bar)[XB_TMO], 1u); break; } } } } while (0)

struct XcdBarrier {
    unsigned* bar; unsigned x;
    volatile LAS unsigned* st;
};

__device__ __forceinline__ XcdBarrier xcd_barrier_post(unsigned* bar, volatile LAS unsigned* st) {
    XcdBarrier b; b.bar = bar; b.x = xb_xcc_id(); b.st = st;
    if (threadIdx.x == 0) (void)xb_add(&bar[XB_XCNT(b.x)], 1u);
    return b;
}
__device__ __forceinline__ void xcd_barrier_complete(unsigned* bar, unsigned x, unsigned& nloc, unsigned& nx) {
    const unsigned G = gridDim.x * gridDim.y * gridDim.z;
    unsigned sum, cnt, mine, sp = 0u;
    for (;;) {
        sum = 0u; cnt = 0u; mine = 0u;
#pragma unroll
        for (unsigned j = 0; j < 16; ++j) { const unsigned c = xb_ld(&bar[XB_XCNT(j)]); sum += c; cnt += (c > 0u) ? 1u : 0u; mine = (j == x) ? c : mine; }
        if (sum == G) break;
        __builtin_amdgcn_s_sleep(1);
        if ((++sp & 255u) == 0u) { if (xb_ld(&bar[XB_TMO])) break; if (sp > XB_SPIN_CAP) { atomicAdd(&bar[XB_TMO], 1u); break; } }
    }
    nloc = mine > 0u ? mine : 1u; nx = cnt > 0u ? cnt : 1u;
}

__device__ __forceinline__ void xcd_barrier(const XcdBarrier& b) {
    asm volatile("s_waitcnt vmcnt(0)" ::: "memory");
    __syncthreads();
    if (threadIdx.x == 0) {
        unsigned* bar = b.bar;
        __builtin_amdgcn_s_waitcnt(0);
        unsigned nloc = b.st[0], nx = b.st[1];
        if (nloc == 0u) { xcd_barrier_complete(bar, b.x, nloc, nx); b.st[0] = nloc; b.st[1] = nx; }
        const unsigned old = xb_add(&bar[XB_XSUB(b.x)], 1u);
        const unsigned gen = old / nloc;
        if (old + 1u == (gen + 1u) * nloc) {
            __builtin_amdgcn_fence(__ATOMIC_RELEASE, "agent");
            asm volatile("s_waitcnt vmcnt(0)" ::: "memory");
            const unsigned og = xb_add(&bar[XB_TOP], 1u);
            const unsigned tg = og / nx;
            if (og + 1u == (tg + 1u) * nx) xb_add(&bar[XB_TOPGEN], 1u);
            else XB_SPIN(xb_ld(&bar[XB_TOPGEN]) == tg, bar);
            __builtin_amdgcn_fence(__ATOMIC_ACQUIRE, "agent");
            xb_add(&bar[XB_XGEN(b.x)], 1u);
            asm volatile("s_waitcnt vmcnt(0)" ::: "memory");
        } else {
            XB_SPIN(xb_ld(&bar[XB_XGEN(b.x)]) == gen, bar);
            __builtin_amdgcn_fence(__ATOMIC_ACQUIRE, "agent");
            asm volatile("s_waitcnt vmcnt(0)" ::: "memory");
        }
    }
    __syncthreads();
}
#ifndef PG8_SP2
#define PG8_SP2 true
#endif
#ifndef PG8_ALIGN
#define PG8_ALIGN true
#endif

__device__ __forceinline__ float* ws_f32(CP p, size_t off) { return (float*)(p.ws + off); }
__device__ __forceinline__ bf16* ws_bf(CP p, size_t off) { return (bf16*)(p.ws + off); }
__device__ __forceinline__ bf16* ws_wt(CP p, size_t eoff) { return (bf16*)(p.ws + WS_WT) + eoff; }

template <int MAP> __device__ __forceinline__ int dmap(int n) {
    if constexpr (MAP == 2) { if (n < 2048) return n; const int j = (n - 2048) & 1023, isg = (n >= 3072) ? 1 : 0; return 2048 + (j >> 7) * 256 + isg * 128 + (j & 127); }
    if constexpr (MAP == 1) { const int h = n >> 8, j = n & 255; return (j < 128) ? (h * 128 + j) : (2048 + h * 128 + j - 128); } else return n; }
template <int MAP = 0> __device__ __forceinline__ void tr_item(const float* W, int K, int N, bf16* WT, const float* gain, LAS float* scr, int item, int lane) {
    const int nblk = N / 64, kb = item / nblk, nb = item % nblk, q = lane & 15, r = lane >> 4, k0 = 64 * kb + 16 * r, n0 = 64 * nb + 4 * q;
    const float* src = W + (size_t)k0 * N + n0;
    f32x4 v[16];
#pragma unroll
    for (int i = 0; i < 16; ++i) v[i] = *(const f32x4*)(src + (size_t)i * N);
    if (gain) {
#pragma unroll
        for (int i = 0; i < 16; ++i) v[i] *= gain[k0 + i]; }
#pragma unroll
    for (int j = 0; j < 4; ++j) {
        u32x4 lo, hi;
        lo.x = pk2(v[0][j], v[1][j]); lo.y = pk2(v[2][j], v[3][j]); lo.z = pk2(v[4][j], v[5][j]); lo.w = pk2(v[6][j], v[7][j]);
        hi.x = pk2(v[8][j], v[9][j]); hi.y = pk2(v[10][j], v[11][j]); hi.z = pk2(v[12][j], v[13][j]); hi.w = pk2(v[14][j], v[15][j]);
        bf16* dst = WT + (size_t)dmap<MAP>(n0 + j) * K + k0;
        *(u32x4*)dst = lo; *(u32x4*)(dst + 8) = hi;
    }
}

__device__ __forceinline__ void ph_prologue(CP p, LAS unsigned char* lds) {
    const int tid = tidx(), lane = tid & 63, wave = tid >> 6;
    const int gw = blockIdx.x * 8 + wave, NGW = gridDim.x * 8;
    LAS float* cact = (LAS float*)lds;
    LAS float* scr = (LAS float*)(lds + 32768 + wave * 8448);
    for (int i = tid; i < NB * D; i += 512) { const float v = p.c[i]; cact[i] = v / (1.f + expf(-v)); }
    __syncthreads();
    float* modp = ws_f32(p, WS_MODP);
    for (int it = gw; it < DEPTH * 48 * 16; it += NGW) {
        const int l = it / (48 * 16), r = it % (48 * 16), jc = r / 16, kc = r % 16;
        const float* w = p.ada_w + ((size_t)l * D + kc * 128) * (6 * D) + jc * 256 + lane * 4;
        f32x4 a0 = {0.f, 0.f, 0.f, 0.f}, a1 = a0, a2 = a0, a3 = a0;
#pragma unroll 8
        for (int k = 0; k < 128; ++k) { const f32x4 wv = *(const f32x4*)(w + (size_t)k * (6 * D)); const int kk = kc * 128 + k;
            a0 += cact[kk] * wv; a1 += cact[D + kk] * wv; a2 += cact[2 * D + kk] * wv; a3 += cact[3 * D + kk] * wv; }
        float* o = modp + ((size_t)(kc * DEPTH + l) * NB) * (6 * D) + jc * 256 + lane * 4;
        *(f32x4*)(o) = a0; *(f32x4*)(o + 6 * D) = a1; *(f32x4*)(o + 12 * D) = a2; *(f32x4*)(o + 18 * D) = a3;
    }
    constexpr int I_ABIN = (D / 64) * (DABIN / 64), I_ABOUT = (D / 64) * (D / 64), I_MLAIN = (D / 64) * (DMLAIN / 64), I_UQ = (QR / 64) * (NH * QKD / 64),
                  I_UKV = (KVR / 64) * (4096 / 64), I_MLAOUT = I_ABOUT, I_W1 = (D / 64) * (DFF / 64), I_W2 = (DFF / 64) * (D / 64);
    constexpr int NITEMS = 2 * (I_ABIN + I_ABOUT + I_MLAIN + I_UQ + I_UKV + I_MLAOUT) + DEPTH * (I_W1 + I_W2);
    for (int it = gw; it < NITEMS; it += NGW) {
        int r = it;
        if (r < 2 * I_ABIN) { const int e = r / I_ABIN; tr_item<2>(p.ab_w_in + (size_t)e * D * DABIN, D, DABIN, ws_wt(p, WT_ABIN) + (size_t)e * DABIN * D, nullptr, scr, r % I_ABIN, lane); continue; } r -= 2 * I_ABIN;
        if (r < 2 * I_ABOUT) { const int e = r / I_ABOUT; tr_item(p.ab_w_out + (size_t)e * D * D, D, D, ws_wt(p, WT_ABOUT) + (size_t)e * D * D, nullptr, scr, r % I_ABOUT, lane); continue; } r -= 2 * I_ABOUT;
        if (r < 2 * I_MLAIN) { const int e = r / I_MLAIN; tr_item(p.mla_w_in + (size_t)e * D * DMLAIN, D, DMLAIN, ws_wt(p, WT_MLAIN) + (size_t)e * DMLAINP * D, nullptr, scr, r % I_MLAIN, lane); continue; } r -= 2 * I_MLAIN;
        if (r < 2 * I_UQ) { const int e = r / I_UQ; tr_item(p.mla_w_uq + (size_t)e * QR * NH * QKD, QR, NH * QKD, ws_wt(p, WT_UQ) + (size_t)e * NH * QKD * QR, p.mla_q_norm_g + (size_t)e * QR, scr, r % I_UQ, lane); continue; } r -= 2 * I_UQ;
        if (r < 2 * I_UKV) { const int e = r / I_UKV; tr_item<1>(p.mla_w_ukv + (size_t)e * KVR * 4096, KVR, 4096, ws_wt(p, WT_UKV) + (size_t)e * 4096 * KVR, p.mla_kv_norm_g + (size_t)e * KVR, scr, r % I_UKV, lane); continue; } r -= 2 * I_UKV;
        if (r < 2 * I_MLAOUT) { const int e = r / I_MLAOUT; tr_item(p.mla_w_out + (size_t)e * D * D, D, D, ws_wt(p, WT_MLAOUT) + (size_t)e * D * D, nullptr, scr, r % I_MLAOUT, lane); continue; } r -= 2 * I_MLAOUT;
        if (r < DEPTH * I_W1) { const int e = r / I_W1; tr_item(p.mlp_w1 + (size_t)e * D * DFF, D, DFF, ws_wt(p, WT_W1) + (size_t)e * DFF * D, nullptr, scr, r % I_W1, lane); continue; } r -= DEPTH * I_W1;
        { const int e = r / I_W2; tr_item(p.mlp_w2 + (size_t)e * DFF * D, DFF, D, ws_wt(p, WT_W2) + (size_t)e * D * DFF, nullptr, scr, r % I_W2, lane); }
    }
    {
        const int gt = blockIdx.x * 512 + tid, NT = gridDim.x * 512;
        constexpr int PADV = (DMLAINP - DMLAIN) * D / 8;
        for (int i = gt; i < 2 * PADV; i += NT) { const int e = i / PADV, r = i % PADV;
            *(u32x4*)(ws_wt(p, WT_MLAIN) + (size_t)e * DMLAINP * D + (size_t)DMLAIN * D + (size_t)r * 8) = (u32x4){0u, 0u, 0u, 0u}; }
        float* rope = ws_f32(p, WS_ROPE);
        for (int idx = gt; idx < SEQ * 32; idx += NT) {
            const int pos = idx >> 5, i = idx & 31;
            const double inv = exp(-(double)i * (9.210340371976184 / 32.0));
            const double a = (double)pos * inv;
            const double q = rint(a * 0.6366197723675814);
            double r = fma(-q, 1.5707963267948966, a); r = fma(-q, 6.123233995736766e-17, r);
            const double r2 = r * r;
            const double sn = r * (1.0 + r2 * (-1.0 / 6.0 + r2 * (1.0 / 120.0 + r2 * (-1.0 / 5040.0 + r2 * (1.0 / 362880.0 + r2 * (-1.0 / 39916800.0 + r2 * (1.0 / 6227020800.0)))))));
            const double cs = 1.0 + r2 * (-0.5 + r2 * (1.0 / 24.0 + r2 * (-1.0 / 720.0 + r2 * (1.0 / 40320.0 + r2 * (-1.0 / 3628800.0 + r2 * (1.0 / 479001600.0 + r2 * (-1.0 / 87178291200.0)))))));
            const int qi = ((int)q) & 3;
            const double s_ = (qi == 0) ? sn : (qi == 1) ? cs : (qi == 2) ? -sn : -cs;
            const double c_ = (qi == 0) ? cs : (qi == 1) ? -sn : (qi == 2) ? -cs : sn;
            rope[pos * 64 + i] = (float)c_; rope[pos * 64 + 32 + i] = (float)s_;
        }
    }
}

__device__ __forceinline__ void ph_modfin(CP p) {
    const int gt = blockIdx.x * 512 + tidx(), NT = gridDim.x * 512;
    const float* modp = ws_f32(p, WS_MODP); float* mod = ws_f32(p, WS_MOD);
    for (int i = gt; i < DEPTH * NB * 6 * D / 4; i += NT) {
        const int e = i * 4, j = e % (6 * D), lb = e / (6 * D), l = lb / NB;
        f32x4 a = *(const f32x4*)(p.ada_b + (size_t)l * 6 * D + j);
#pragma unroll
        for (int kc = 0; kc < 16; ++kc) a += *(const f32x4*)(modp + ((size_t)kc * DEPTH * NB + lb) * (6 * D) + j);
        *(f32x4*)(mod + (size_t)lb * 6 * D + j) = a;
    }
}

__device__ __forceinline__ void ph_norm(CP p, int l, int which, const float* xsrc, const bf16* xsb) {
    const int lane = tidx() & 63, gw = blockIdx.x * 8 + (tidx() >> 6), NGW = gridDim.x * 8;
    const float* g = (which ? p.norm2_g : p.norm1_g) + (size_t)l * D;
    const float* mod = ws_f32(p, WS_MOD) + (size_t)l * NB * 6 * D;
    bf16* H = ws_bf(p, WS_H);
    const int per = (M + NGW - 1) / NGW, r_lo = gw * per, r_hi = (r_lo + per < M) ? r_lo + per : M;
    int bcur = -1; f32x4 G[8], S[8];
    for (int row = r_lo; row < r_hi; ++row) {
        const int b = row / SEQ;
        if (b != bcur) { bcur = b; const float* sh = mod + (size_t)b * 6 * D + (which ? 3 : 0) * D; const float* sc = sh + D;
#pragma unroll
            for (int j = 0; j < 4; ++j)
#pragma unroll
                for (int q = 0; q < 2; ++q) { const int col = 8 * lane + 512 * j + 4 * q; G[2 * j + q] = *(const f32x4*)(g + col) * (1.0f + *(const f32x4*)(sc + col)); S[2 * j + q] = *(const f32x4*)(sh + col); } }
        f32x4 v[8]; float ss = 0.f;
        if (xsb) { const u32x4* xr = (const u32x4*)(xsb + (size_t)row * D) + lane;
#pragma unroll
            for (int j = 0; j < 4; ++j) { const u32x4 w = xr[64 * j]; v[2 * j] = (f32x4){bf_lo(w.x), bf_hi(w.x), bf_lo(w.y), bf_hi(w.y)}; v[2 * j + 1] = (f32x4){bf_lo(w.z), bf_hi(w.z), bf_lo(w.w), bf_hi(w.w)}; }
        } else { const f32x4* xr = (const f32x4*)(xsrc + (size_t)row * D) + 2 * lane;
#pragma unroll
            for (int j = 0; j < 4; ++j) { v[2 * j] = xr[128 * j]; v[2 * j + 1] = xr[128 * j + 1]; } }
#pragma unroll
        for (int j = 0; j < 8; ++j) ss += (v[j].x * v[j].x + v[j].y * v[j].y) + (v[j].z * v[j].z + v[j].w * v[j].w);
        const float r = 1.0f / sqrtf(wave_sum(ss) * (1.0f / D) + EPS);
        u32x4* o = (u32x4*)(H + (size_t)row * D) + lane;
#pragma unroll
        for (int j = 0; j < 4; ++j) { const f32x4 h0 = v[2 * j] * r * G[2 * j] + S[2 * j], h1 = v[2 * j + 1] * r * G[2 * j + 1] + S[2 * j + 1];
            o[64 * j] = (u32x4){pk2(h0.x, h0.y), pk2(h0.z, h0.w), pk2(h1.x, h1.y), pk2(h1.z, h1.w)}; }
    }
}

__device__ __forceinline__ void ph_even_post(CP p, int e) {
    const int lane = tidx() & 63, gw = blockIdx.x * 8 + (tidx() >> 6), NGW = gridDim.x * 8;
    const float* RAW = ws_f32(p, WS_RAW); bf16* U = ws_bf(p, WS_U); bf16* VN = ws_bf(p, WS_VN); bf16* Y = ws_bf(p, WS_Y);
    const float* gn = p.sgu_norm_g + (size_t)e * DA;
    for (int row = gw; row < M; row += NGW) {
        const float* r = RAW + (size_t)row * DABIN;
        for (int j = lane * 4; j < DA; j += 256) { const f32x4 u = *(const f32x4*)(r + j);
            *(u32x2*)(U + (size_t)row * DA + j) = (u32x2){pk2(gelu_tanh(u.x), gelu_tanh(u.y)), pk2(gelu_tanh(u.z), gelu_tanh(u.w))}; }
        for (int g = 0; g < NG; ++g) { const int j = g * GD + lane * 2; const f32x2 vv = *(const f32x2*)(r + DA + j);
            const float v0 = gelu_tanh(vv.x), v1 = gelu_tanh(vv.y);
            const float rr = 1.0f / sqrtf(wave_sum(v0 * v0 + v1 * v1) * (1.0f / GD) + EPS);
            *(unsigned*)(VN + (size_t)row * DA + j) = pk2(v0 * rr * gn[j], v1 * rr * gn[j + 1]); }
        for (int j = lane * 4; j < DA; j += 256) { const f32x4 a = *(const f32x4*)(r + 2 * DA + j), gg = *(const f32x4*)(r + 3 * DA + j);
            *(u32x2*)(Y + (size_t)row * DA + j) = (u32x2){pk2(a.x * sigmoidf_(gg.x), a.y * sigmoidf_(gg.y)), pk2(a.z * sigmoidf_(gg.z), a.w * sigmoidf_(gg.w))}; }
    }
}

__device__ __forceinline__ void ph_sgu_naive(CP p, int e, LAS unsigned char* lds) {
    const int tid = tidx();
    LAS float* vl = (LAS float*)lds; LAS float* wl = (LAS float*)(lds + 65536);
    const bf16* U = ws_bf(p, WS_U); const bf16* VN = ws_bf(p, WS_VN); bf16* AB = ws_bf(p, WS_AB);
    for (int unit = blockIdx.x; unit < NB * (SEQ / 128) * NG; unit += gridDim.x) {
        const int g = unit % NG, row0 = (unit / NG) * 128;
        const float* w = p.sgu_w + ((size_t)e * NG + g) * 128 * 128; const float* bs = p.sgu_b + ((size_t)e * NG + g) * 128;
        for (int i = tid; i < 128 * 128; i += 512) { const int s = i >> 7, d = i & 127; vl[i] = bf2f(VN[(size_t)(row0 + s) * DA + g * GD + d]);
            const int t = i >> 7, ss = i & 127; wl[i] = (ss <= t) ? w[i] : 0.f; }
        __syncthreads();
        const int d = tid & 127, tq = tid >> 7;
        for (int i = 0; i < 32; ++i) { const int t = tq + 4 * i; float acc = 0.f;
            for (int s = 0; s <= t; ++s) acc += wl[t * 128 + s] * vl[s * 128 + d];
            const float mixed = acc + bs[t];
            const size_t ro = (size_t)(row0 + t);
            AB[ro * D + g * GD + d] = (bf16)f2bf(bf2f(U[ro * DA + g * GD + d]) * mixed); }
        __syncthreads();
    }
}

__device__ __forceinline__ void ph_conv_naive(CP p, int e) {
    const int gt = blockIdx.x * 512 + tidx(), NT = gridDim.x * 512;
    const bf16* Y = ws_bf(p, WS_Y); float* Z = ws_f32(p, WS_Z);
    const float* cw = p.conv_w + (size_t)e * CONVW * DA; const float* cb = p.conv_b + (size_t)e * DA;
    for (int idx = gt; idx < M * (DA / 2); idx += NT) {
        const int row = idx / (DA / 2), ch = (idx % (DA / 2)) * 2, t = row % SEQ;
        float a0 = cb[ch], a1 = cb[ch + 1];
        for (int j = 0; j < CONVW; ++j) { const int tt = t - (CONVW - 1) + j;
            if (tt >= 0) { const unsigned y = *(const unsigned*)(Y + (size_t)(row - (CONVW - 1) + j) * DA + ch);
                a0 += cw[j * DA + ch] * bf_lo(y); a1 += cw[j * DA + ch + 1] * bf_hi(y); } }
        *(f32x2*)(Z + (size_t)row * DA + ch) = (f32x2){a0, a1};
    }
}
__device__ __forceinline__ void ph_convln(CP p, int e) {
    const int lane = tidx() & 63, gw = blockIdx.x * 8 + (tidx() >> 6), NGW = gridDim.x * 8;
    const bf16* Z = ws_bf(p, WS_Z); bf16* AB = ws_bf(p, WS_AB);
    const float* lg = p.conv_ln_g + (size_t)e * DA; const float* lb = p.conv_ln_b + (size_t)e * DA;
    f32x4 Gv[4], Bv[4];
#pragma unroll
    for (int j = 0; j < 2; ++j)
#pragma unroll
        for (int q = 0; q < 2; ++q) { const int col = 8 * lane + 512 * j + 4 * q; Gv[2 * j + q] = *(const f32x4*)(lg + col); Bv[2 * j + q] = *(const f32x4*)(lb + col); }
    const int per = (M + NGW - 1) / NGW, r_lo = gw * per, r_hi = (r_lo + per < M) ? r_lo + per : M;
    for (int row = r_lo; row < r_hi; ++row) {
        const u32x4* zr = (const u32x4*)(Z + (size_t)row * DA) + lane; f32x4 v[4]; float s = 0.f;
#pragma unroll
        for (int j = 0; j < 2; ++j) { const u32x4 w = zr[64 * j]; v[2 * j] = (f32x4){bf_lo(w.x), bf_hi(w.x), bf_lo(w.y), bf_hi(w.y)}; v[2 * j + 1] = (f32x4){bf_lo(w.z), bf_hi(w.z), bf_lo(w.w), bf_hi(w.w)}; }
#pragma unroll
        for (int j = 0; j < 4; ++j) s += (v[j].x + v[j].y) + (v[j].z + v[j].w);
        const float mean = wave_sum(s) * (1.0f / DA); float q = 0.f;
#pragma unroll
        for (int j = 0; j < 4; ++j) { v[j] = v[j] - mean; q += (v[j].x * v[j].x + v[j].y * v[j].y) + (v[j].z * v[j].z + v[j].w * v[j].w); }
        const float rstd = 1.0f / sqrtf(wave_sum(q) * (1.0f / DA) + EPS);
        u32x4* o = (u32x4*)(AB + (size_t)row * D + DA) + lane;
#pragma unroll
        for (int j = 0; j < 2; ++j) { u32x4 w;
#pragma unroll
            for (int qq = 0; qq < 2; ++qq) { f32x4 y = v[2 * j + qq] * rstd * Gv[2 * j + qq] + Bv[2 * j + qq]; y.x *= sigmoidf_(y.x); y.y *= sigmoidf_(y.y); y.z *= sigmoidf_(y.z); y.w *= sigmoidf_(y.w);
                if (qq == 0) { w.x = pk2(y.x, y.y); w.y = pk2(y.z, y.w); } else { w.z = pk2(y.x, y.y); w.w = pk2(y.z, y.w); } }
            o[64 * j] = w; }
    }
}

__device__ __forceinline__ void ph_mla_mid(CP p, int o) {
    const int lane = tidx() & 63, gw = blockIdx.x * 8 + (tidx() >> 6), NGW = gridDim.x * 8;
    bf16* CQ = ws_bf(p, WS_CQ); bf16* CKV = ws_bf(p, WS_CKV);
    const float* gq = p.mla_q_norm_g + (size_t)o * QR + lane * 8; const float* gkv = p.mla_kv_norm_g + (size_t)o * KVR + lane * 8;
    const f32x4 gq0 = *(const f32x4*)gq, gq1 = *(const f32x4*)(gq + 4), gk0 = *(const f32x4*)gkv, gk1 = *(const f32x4*)(gkv + 4);
    const int per = (M + NGW - 1) / NGW, r_lo = gw * per, r_hi = (r_lo + per < M) ? r_lo + per : M;
    for (int row = r_lo; row < r_hi; ++row) {
#pragma unroll
        for (int part = 0; part < 2; ++part) {
            bf16* ptr = (part ? CKV : CQ) + (size_t)row * QR + lane * 8;
            const u32x4 v = *(const u32x4*)ptr;
            float f[8] = {bf_lo(v.x), bf_hi(v.x), bf_lo(v.y), bf_hi(v.y), bf_lo(v.z), bf_hi(v.z), bf_lo(v.w), bf_hi(v.w)};
            float ss = 0.f;
#pragma unroll
            for (int j = 0; j < 8; ++j) ss += f[j] * f[j];
            const float rr = 1.0f / sqrtf(wave_sum(ss) * (1.0f / QR) + EPS);
            const f32x4 g0 = part ? gk0 : gq0, g1 = part ? gk1 : gq1;
            u32x4 o4; o4.x = pk2(f[0] * rr * g0.x, f[1] * rr * g0.y); o4.y = pk2(f[2] * rr * g0.z, f[3] * rr * g0.w); o4.z = pk2(f[4] * rr * g1.x, f[5] * rr * g1.y); o4.w = pk2(f[6] * rr * g1.z, f[7] * rr * g1.w);
            *(u32x4*)ptr = o4;
        }
    }
}
__device__ __forceinline__ void kr_post(CP p, int o, int r0) {
    const int lane = tidx() & 63, wv = tidx() >> 6;
    bf16* KR = ws_bf(p, WS_KR); const float* rope = ws_f32(p, WS_ROPE);
    const float krg = (p.mla_k_head_g + (size_t)o * QKD)[NOPE + lane];
    constexpr int NR = 8;
    for (int g = 0; g < 4; ++g) { const int row = r0 + 32 * wv + NR * g;
        float kv[NR], cs[NR], sn[NR];
#pragma unroll
        for (int i = 0; i < NR; ++i) { const int pos = (row + i) % SEQ; kv[i] = bf2f(KR[(size_t)(row + i) * ROPE + lane]); cs[i] = rope[pos * 64 + (lane & 31)]; sn[i] = rope[pos * 64 + 32 + (lane & 31)]; }
#pragma unroll
        for (int i = 0; i < NR; ++i) {
            const float rrk = 1.0f / sqrtf(wave_sum(kv[i] * kv[i]) * (1.0f / ROPE) + EPS);
            const float vn = kv[i] * rrk * krg, partner = __shfl_xor(vn, 32);
            const float outv = (lane < 32) ? (vn * cs[i] - partner * sn[i]) : (partner * sn[i] + vn * cs[i]);
            KR[(size_t)(row + i) * ROPE + lane] = (bf16)f2bf(outv); }
    }
}
__device__ __forceinline__ void ph_k_norm(CP p, int o) {
    const int lane = tidx() & 63, gw = blockIdx.x * 8 + (tidx() >> 6), NGW = gridDim.x * 8;
    bf16* KR = ws_bf(p, WS_KR); const float* rope = ws_f32(p, WS_ROPE);
    const float krg = (p.mla_k_head_g + (size_t)o * QKD)[NOPE + lane];
    const int per = (M + NGW - 1) / NGW, r_lo = gw * per, r_hi = (r_lo + per < M) ? r_lo + per : M;
    constexpr int NR = 8;
    for (int row = r_lo; row < r_hi; row += NR) {
        float kv[NR], cs[NR], sn[NR];
#pragma unroll
        for (int i = 0; i < NR; ++i) { const int rr = (row + i < r_hi) ? row + i : r_hi - 1, pos = rr % SEQ;
            kv[i] = bf2f(KR[(size_t)rr * ROPE + lane]); cs[i] = rope[pos * 64 + (lane & 31)]; sn[i] = rope[pos * 64 + 32 + (lane & 31)]; }
#pragma unroll
        for (int i = 0; i < NR; ++i) if (row + i < r_hi) {
            const float rrk = 1.0f / sqrtf(wave_sum(kv[i] * kv[i]) * (1.0f / ROPE) + EPS);
            const float vn = kv[i] * rrk * krg, partner = __shfl_xor(vn, 32);
            const float outv = (lane < 32) ? (vn * cs[i] - partner * sn[i]) : (partner * sn[i] + vn * cs[i]);
            KR[(size_t)(row + i) * ROPE + lane] = (bf16)f2bf(outv); }
    }
}
__device__ __forceinline__ void ph_attn_naive(CP p, LAS unsigned char* lds) {
    const int lane = tidx() & 63, wave = tidx() >> 6, gw = blockIdx.x * 8 + wave, NGW = gridDim.x * 8;
    const bf16* Q = ws_bf(p, WS_Q); const bf16* KN = ws_bf(p, WS_KN); const bf16* KR = ws_bf(p, WS_KR); const bf16* V = ws_bf(p, WS_V); bf16* O = ws_bf(p, WS_O);
    LAS float* ql = (LAS float*)lds + wave * 192;
    for (int idx = gw; idx < NB * NH * SEQ; idx += NGW) {
        const int bh = idx / SEQ, qq = idx % SEQ, q = (bh & 1) ? (SEQ - 1 - qq) : qq, b = bh / NH, h = bh % NH;
        const size_t rowq = (size_t)b * SEQ + q;
        const bf16* qp = Q + (rowq * NH + h) * QKD;
        ql[lane] = bf2f(qp[lane]); ql[64 + lane] = bf2f(qp[64 + lane]); ql[128 + lane] = bf2f(qp[128 + lane]);
        asm volatile("s_waitcnt lgkmcnt(0)" ::: "memory");
        float mrun = -1e30f, lrun = 0.f, o0 = 0.f, o1 = 0.f;
        for (int kc = 0; kc <= q; kc += 64) {
            const int key = kc + lane; const size_t rowk = (size_t)b * SEQ + key;
            float s = 0.f;
            const u32x4* kn = (const u32x4*)(KN + rowk * D + h * NOPE);
#pragma unroll 4
            for (int c = 0; c < 16; ++c) { const u32x4 w = kn[c]; const LAS float* qv = ql + c * 8;
                s += qv[0] * bf_lo(w.x) + qv[1] * bf_hi(w.x) + qv[2] * bf_lo(w.y) + qv[3] * bf_hi(w.y) + qv[4] * bf_lo(w.z) + qv[5] * bf_hi(w.z) + qv[6] * bf_lo(w.w) + qv[7] * bf_hi(w.w); }
            const u32x4* kr = (const u32x4*)(KR + rowk * ROPE);
#pragma unroll 4
            for (int c = 0; c < 8; ++c) { const u32x4 w = kr[c]; const LAS float* qv = ql + 128 + c * 8;
                s += qv[0] * bf_lo(w.x) + qv[1] * bf_hi(w.x) + qv[2] * bf_lo(w.y) + qv[3] * bf_hi(w.y) + qv[4] * bf_lo(w.z) + qv[5] * bf_hi(w.z) + qv[6] * bf_lo(w.w) + qv[7] * bf_hi(w.w); }
            if (key > q) s = -__builtin_inff();
            const float mnew = fmaxf(mrun, wave_max(s));
            const float pr = __builtin_amdgcn_exp2f(s - mnew), alpha = __builtin_amdgcn_exp2f(mrun - mnew);
            lrun = lrun * alpha + wave_sum(pr); o0 *= alpha; o1 *= alpha; mrun = mnew;
            const bf16* vp = V + ((size_t)b * SEQ + kc) * D + h * VD + lane * 2;
#pragma unroll 8
            for (int kk = 0; kk < 64; ++kk) { const float pk = __builtin_bit_cast(float, __builtin_amdgcn_readlane(__builtin_bit_cast(int, pr), kk));
                const unsigned w = *(const unsigned*)(vp + (size_t)kk * D); o0 += pk * bf_lo(w); o1 += pk * bf_hi(w); }
        }
        const float il = 1.0f / lrun;
        *(unsigned*)(O + rowq * D + h * VD + lane * 2) = pk2(o0 * il, o1 * il);
    }
}

typedef float f32x16 __attribute__((ext_vector_type(16)));
constexpr int AT_KPITCH = 400, AT_VPITCH = 144;
constexpr int AT_KBUF = 64 * AT_KPITCH, AT_VBUF = 128 * AT_VPITCH;
constexpr int AT_K0 = 0, AT_V0 = 2 * AT_KBUF;
#ifndef AT_PRIO_MODE
#define AT_PRIO_MODE 1
#endif
#if AT_PRIO_MODE == 1
#define AT_PRIO(x) __builtin_amdgcn_s_setprio(x)
#else
#define AT_PRIO(x) do {} while (0)
#endif
#ifndef AT_VDEPTH
#define AT_VDEPTH 3
#endif
#ifndef AT_KDEPTH
#define AT_KDEPTH 3
#endif
constexpr float AT_THR = 8.0f;

__device__ __forceinline__ float half_max(float x) {
    float a = x, b = x;
    asm volatile("s_nop 1\n\tv_permlane32_swap_b32 %0, %1" : "+v"(a), "+v"(b));
    return fmaxf(a, b); }
__device__ __forceinline__ float half_sum(float x) { return x + __shfl_xor(x, 32); }

template <bool FAST> __device__ __forceinline__ void attn_unit(const bf16* Q, const bf16* KN, const bf16* KR, const bf16* VT, bf16* O, const float* qhg_in, const float* rope_in, const float* msq_in, LAS unsigned char* lds, int b, int h, int qb, int tid) {
    const float* qhg = qhg_in; const float* rope = rope_in; const float* msq = msq_in; asm volatile("" : "+s"(qhg), "+s"(rope), "+s"(msq));
    int lane = tid & 63; asm volatile("" : "+v"(lane));
    const int w = __builtin_amdgcn_readfirstlane(tid >> 6), r32 = lane & 31, hi = lane >> 5;
    const size_t rowbase = (size_t)b * SEQ;
    const int qrow = 256 * qb + 32 * w + r32;
    bf16x8 qf[12];
    {
        const bf16* qp = Q + ((rowbase + qrow) * NH + h) * QKD + 8 * hi;
        float ssn = 0.f, ssr = 0.f;
#pragma unroll
        for (int kk = 0; kk < 12; ++kk) { qf[kk] = *(const bf16x8*)(qp + 16 * kk); const u32x4 v = __builtin_bit_cast(u32x4, qf[kk]);
            const float s8 = (bf_lo(v.x) * bf_lo(v.x) + bf_hi(v.x) * bf_hi(v.x)) + (bf_lo(v.y) * bf_lo(v.y) + bf_hi(v.y) * bf_hi(v.y)) + (bf_lo(v.z) * bf_lo(v.z) + bf_hi(v.z) * bf_hi(v.z)) + (bf_lo(v.w) * bf_lo(v.w) + bf_hi(v.w) * bf_hi(v.w));
            if (kk < 8) ssn += s8; else ssr += s8; }
        ssn = half_sum(ssn); ssr = half_sum(ssr);
        const f32x4 pa = *(const f32x4*)(msq + (rowbase + qrow) * 16), pb = *(const f32x4*)(msq + (rowbase + qrow) * 16 + 4);
        const float epsq = EPS * ((((pa[0] + pa[1]) + (pa[2] + pa[3])) + ((pb[0] + pb[1]) + (pb[2] + pb[3]))) * (1.0f / QR) + EPS);
        const float rn = QSCALE / sqrtf(ssn * (1.0f / NOPE) + epsq), rr = QSCALE / sqrtf(ssr * (1.0f / ROPE) + epsq);
#pragma unroll
        for (int kk = 0; kk < 8; ++kk) { const u32x4 v = __builtin_bit_cast(u32x4, qf[kk]);
            const u32x4 wq = {cvtpk(bf_lo(v.x) * rn, bf_hi(v.x) * rn), cvtpk(bf_lo(v.y) * rn, bf_hi(v.y) * rn), cvtpk(bf_lo(v.z) * rn, bf_hi(v.z) * rn), cvtpk(bf_lo(v.w) * rn, bf_hi(v.w) * rn)};
            qf[kk] = __builtin_bit_cast(bf16x8, wq); }
#pragma unroll
        for (int kk = 8; kk < 10; ++kk) {
            const int j0 = 16 * (kk - 8) + 8 * hi; const float* rp = rope + (size_t)qrow * 64 + j0; const float* gp = qhg + NOPE + j0;
            const u32x4 a = __builtin_bit_cast(u32x4, qf[kk]), bq = __builtin_bit_cast(u32x4, qf[kk + 2]);
            const f32x4 c0 = *(const f32x4*)rp, c1 = *(const f32x4*)(rp + 4), s0 = *(const f32x4*)(rp + 32), s1 = *(const f32x4*)(rp + 36);
            const f32x4 ga0 = *(const f32x4*)gp * rr, ga1 = *(const f32x4*)(gp + 4) * rr, gb0 = *(const f32x4*)(gp + 32) * rr, gb1 = *(const f32x4*)(gp + 36) * rr;
            const f32x4 x10 = (f32x4){bf_lo(a.x), bf_hi(a.x), bf_lo(a.y), bf_hi(a.y)} * ga0, x11 = (f32x4){bf_lo(a.z), bf_hi(a.z), bf_lo(a.w), bf_hi(a.w)} * ga1;
            const f32x4 x20 = (f32x4){bf_lo(bq.x), bf_hi(bq.x), bf_lo(bq.y), bf_hi(bq.y)} * gb0, x21 = (f32x4){bf_lo(bq.z), bf_hi(bq.z), bf_lo(bq.w), bf_hi(bq.w)} * gb1;
            const f32x4 o10 = x10 * c0 - x20 * s0, o11 = x11 * c1 - x21 * s1, o20 = x10 * s0 + x20 * c0, o21 = x11 * s1 + x21 * c1;
            const u32x4 w1 = {cvtpk(o10[0], o10[1]), cvtpk(o10[2], o10[3]), cvtpk(o11[0], o11[1]), cvtpk(o11[2], o11[3])}, w2 = {cvtpk(o20[0], o20[1]), cvtpk(o20[2], o20[3]), cvtpk(o21[0], o21[1]), cvtpk(o21[2], o21[3])};
            qf[kk] = __builtin_bit_cast(bf16x8, w1); qf[kk + 2] = __builtin_bit_cast(bf16x8, w2); }
    }
    f32x16 o[4];
#pragma unroll
    for (int d = 0; d < 4; ++d)
#pragma unroll
        for (int r = 0; r < 16; ++r) o[d][r] = 0.f;
    float m_run = -1e30f, l_run = 0.f;
    const int ntiles = 4 * (qb + 1), jdiag = 4 * qb + (w >> 1);
    const int kn_key = tid >> 4, kn_part = tid & 15;
    const int kr_key = tid >> 3, kr_part = tid & 7;
    const int vt_d = tid >> 3, vt_part = tid & 7;
    const bf16* gkn = KN + (rowbase + kn_key) * D + h * NOPE + kn_part * 8;
    const bf16* gkr = KR + (rowbase + kr_key) * ROPE + kr_part * 8;
    const bf16* gvt = VT + (size_t)(h * VD + vt_d) * M + rowbase + vt_part * 8;
    const int l_kn = kn_key * AT_KPITCH + kn_part * 16, l_kr = kr_key * AT_KPITCH + 256 + kr_part * 16, l_vt = vt_d * AT_VPITCH + (vt_part >> 1) * 32 + (vt_part & 1) * 8;
    u32x4 st0, st1, st2, st3, st4;
#define AT_LOAD(j) do { st0 = *(const u32x4*)(gkn + (size_t)(64 * (j)) * D); st1 = *(const u32x4*)(gkn + (size_t)(64 * (j) + 32) * D); st2 = *(const u32x4*)(gkr + (size_t)(64 * (j)) * ROPE); \
        st3 = *(const u32x4*)(gvt + 64 * (j)); st4 = *(const u32x4*)(gvt + (size_t)64 * M + 64 * (j)); } while (0)
#define AT_STORE(bf) do { LAS unsigned char* kb_ = lds + AT_K0 + (bf) * AT_KBUF; LAS unsigned char* vb_ = lds + AT_V0 + (bf) * AT_VBUF; \
        *(LAS u32x4*)(kb_ + l_kn) = st0; *(LAS u32x4*)(kb_ + l_kn + 32 * AT_KPITCH) = st1; *(LAS u32x4*)(kb_ + l_kr) = st2; \
        *(LAS u32x2*)(vb_ + l_vt) = (u32x2){st3.x, st3.y}; *(LAS u32x2*)(vb_ + l_vt + 16) = (u32x2){st3.z, st3.w}; \
        *(LAS u32x2*)(vb_ + l_vt + 64 * AT_VPITCH) = (u32x2){st4.x, st4.y}; *(LAS u32x2*)(vb_ + l_vt + 64 * AT_VPITCH + 16) = (u32x2){st4.z, st4.w}; } while (0)
    AT_LOAD(0); AT_STORE(0);
    __syncthreads();
    const int k_rd = r32 * AT_KPITCH + hi * 16;
    const int v_rd = r32 * AT_VPITCH + hi * 16;
    for (int j = 0; j < ntiles; ++j) {
        const int bf = j & 1;
        if (j + 1 < ntiles) AT_LOAD(j + 1);
        LAS unsigned char* vb_ = lds + AT_V0 + bf * AT_VBUF + v_rd; bf16x8 va[AT_VDEPTH], pf[4];
        if (j <= jdiag) {
            LAS unsigned char* kb_ = lds + AT_K0 + bf * AT_KBUF + k_rd;
            f32x16 s0, s1;
#pragma unroll
            for (int r = 0; r < 16; ++r) { s0[r] = 0.f; s1[r] = 0.f; }
            {
                bf16x8 ka[AT_KDEPTH][2];
#pragma unroll
                for (int q = 0; q < AT_KDEPTH; ++q) { ka[q][0] = *(const LAS bf16x8*)(kb_ + q * 32); ka[q][1] = *(const LAS bf16x8*)(kb_ + 32 * AT_KPITCH + q * 32); }
                __builtin_amdgcn_sched_barrier(0);
                AT_PRIO(1);
#pragma unroll
                for (int kk = 0; kk < 12; ++kk) { const int cur = kk % AT_KDEPTH;
                    s0 = __builtin_amdgcn_mfma_f32_32x32x16_bf16(ka[cur][0], qf[kk], s0, 0, 0, 0);
                    s1 = __builtin_amdgcn_mfma_f32_32x32x16_bf16(ka[cur][1], qf[kk], s1, 0, 0, 0);
                    if (kk + AT_KDEPTH < 12) { ka[cur][0] = *(const LAS bf16x8*)(kb_ + (kk + AT_KDEPTH) * 32); ka[cur][1] = *(const LAS bf16x8*)(kb_ + 32 * AT_KPITCH + (kk + AT_KDEPTH) * 32); }
                    __builtin_amdgcn_sched_barrier(0);
                }
            }
            AT_PRIO(0);
#pragma unroll
            for (int q = 0; q < AT_VDEPTH; ++q) va[q] = *(const LAS bf16x8*)(vb_ + (q & 3) * 32 * AT_VPITCH + (q >> 2) * 32);
            __builtin_amdgcn_sched_barrier(0);
            if (j == jdiag) {
                int dq = qrow - 64 * j - 4 * hi;
                asm volatile("" : "+v"(dq));
#pragma unroll
                for (int r = 0; r < 16; ++r) { const int c = (r & 3) + 8 * (r >> 2);
                    if (c > dq) s0[r] = -__builtin_inff();
                    if (c + 32 > dq) s1[r] = -__builtin_inff(); }
            }
            if constexpr (!FAST) {
            float mx = s0[0];
#pragma unroll
            for (int r = 1; r < 16; ++r) mx = fmaxf(mx, s0[r]);
#pragma unroll
            for (int r = 0; r < 16; ++r) mx = fmaxf(mx, s1[r]);
            mx = half_max(mx);
            if (!__all(mx - m_run <= AT_THR)) {
                const float mnew = fmaxf(m_run, mx), alpha = __builtin_amdgcn_exp2f(m_run - mnew);
                m_run = mnew; l_run *= alpha;
#pragma unroll
                for (int d = 0; d < 4; ++d)
#pragma unroll
                    for (int r = 0; r < 16; ++r) o[d][r] *= alpha;
            }
            }
#define AT_VFRAG(i) (*(const LAS bf16x8*)(vb_ + ((i) & 3) * 32 * AT_VPITCH + ((i) >> 2) * 32))
            float ps = 0.f;
#define AT_SQ(q, r) ((q) < 2 ? s0[8 * ((q) & 1) + (r)] : s1[8 * ((q) & 1) + (r)])
#define AT_PACKQ(q) do { const u32x4 pk_ = {cvtpk(AT_SQ(q, 0), AT_SQ(q, 1)), cvtpk(AT_SQ(q, 2), AT_SQ(q, 3)), cvtpk(AT_SQ(q, 4), AT_SQ(q, 5)), cvtpk(AT_SQ(q, 6), AT_SQ(q, 7))}; pf[q] = __builtin_bit_cast(bf16x8, pk_); } while (0)
#pragma unroll
            for (int r = 0; r < 8; ++r) { s0[r] = __builtin_amdgcn_exp2f(FAST ? s0[r] : s0[r] - m_run); ps += s0[r]; }
            AT_PACKQ(0);
            AT_PRIO(1);
            __builtin_amdgcn_sched_barrier(0);
#pragma unroll
            for (int q = 1; q < 4; ++q) {
#pragma unroll
                for (int d = 0; d < 4; ++d) { const int i = 4 * (q - 1) + d, cur = i % AT_VDEPTH;
                    o[d] = __builtin_amdgcn_mfma_f32_32x32x16_bf16(va[cur], pf[q - 1], o[d], 0, 0, 0);
                    va[cur] = AT_VFRAG(i + AT_VDEPTH);
                    if (q == 1) { s0[8 + 2 * d] = __builtin_amdgcn_exp2f(FAST ? s0[8 + 2 * d] : s0[8 + 2 * d] - m_run); s0[9 + 2 * d] = __builtin_amdgcn_exp2f(FAST ? s0[9 + 2 * d] : s0[9 + 2 * d] - m_run); ps += s0[8 + 2 * d] + s0[9 + 2 * d]; }
                    else { const int r0 = 8 * (q & 1) + 2 * d; s1[r0] = __builtin_amdgcn_exp2f(FAST ? s1[r0] : s1[r0] - m_run); s1[r0 + 1] = __builtin_amdgcn_exp2f(FAST ? s1[r0 + 1] : s1[r0 + 1] - m_run); ps += s1[r0] + s1[r0 + 1]; }
                    __builtin_amdgcn_sched_barrier(0);
                }
                if (q == 1) AT_PACKQ(1); else if (q == 2) AT_PACKQ(2); else AT_PACKQ(3);
                __builtin_amdgcn_sched_barrier(0);
            }
            l_run += ps;
#undef AT_SQ
#undef AT_PACKQ
        }
        if (j + 1 < ntiles) AT_STORE(bf ^ 1);
        if (j <= jdiag) {
            __builtin_amdgcn_sched_barrier(0);
#pragma unroll
            for (int i = 12; i < 16; ++i) { const int cur = i % AT_VDEPTH;
                o[i & 3] = __builtin_amdgcn_mfma_f32_32x32x16_bf16(va[cur], pf[i >> 2], o[i & 3], 0, 0, 0);
                if (i + AT_VDEPTH < 16) va[cur] = AT_VFRAG(i + AT_VDEPTH);
                __builtin_amdgcn_sched_barrier(0);
            }
            AT_PRIO(0);
        }
#undef AT_VFRAG
        __syncthreads();
    }
#undef AT_LOAD
#undef AT_STORE
    const float il = 1.0f / half_sum(l_run);
    bf16* op = O + (rowbase + qrow) * D + h * VD + 8 * hi;
#pragma unroll
    for (int d = 0; d < 4; ++d)
#pragma unroll
        for (int gp = 0; gp < 2; ++gp) {
            const u32x2 ev = {cvtpk(o[d][8 * gp + 0] * il, o[d][8 * gp + 1] * il), cvtpk(o[d][8 * gp + 2] * il, o[d][8 * gp + 3] * il)};
            const u32x2 od = {cvtpk(o[d][8 * gp + 4] * il, o[d][8 * gp + 5] * il), cvtpk(o[d][8 * gp + 6] * il, o[d][8 * gp + 7] * il)};
            const u32x2 snd = hi ? ev : od;
            const u32x2 rcv = {(unsigned)__shfl_xor((int)snd.x, 32), (unsigned)__shfl_xor((int)snd.y, 32)};
            const u32x4 wv = hi ? (u32x4){rcv.x, rcv.y, od.x, od.y} : (u32x4){ev.x, ev.y, rcv.x, rcv.y};
            *(u32x4*)(op + 32 * d + 16 * gp) = wv;
        }
}

__device__ __forceinline__ void ph_attn(CP p, int oidx, LAS unsigned char* lds) {
    const int tid = tidx(); const float* qhg = p.mla_q_head_g + (size_t)oidx * QKD; const float* rope = ws_f32(p, WS_ROPE); const float* msq = ws_f32(p, WS_MSQ);
    const int G = gridDim.x, bx = blockIdx.x, vcu = (G % 8 == 0) ? (bx % 8) * (G / 8) + bx / 8 : bx;
    const bf16* Q = ws_bf(p, WS_Q); const bf16* KN = ws_bf(p, WS_KN); const bf16* KR = ws_bf(p, WS_KR); const bf16* VT = ws_bf(p, WS_VT); bf16* O = ws_bf(p, WS_O);
    const float* khg = p.mla_k_head_g + (size_t)oidx * QKD; const int ln = tid & 63;
    const float g1 = wave_max(fmaxf(fabsf(khg[ln] * qhg[ln]), fabsf(khg[ln + 64] * qhg[ln + 64]))), g2q = wave_max(fabsf(qhg[NOPE + ln])), g2k = wave_max(fabsf(khg[NOPE + ln]));
    const float sbound = QSCALE * (128.f * g1 + 64.f * g2q * g2k);
    const bool fast = __builtin_amdgcn_readfirstlane((int)(sbound < 96.f)) != 0;
    for (int item = vcu; item < NB * NH * 8; item += G) {
        const int bh = item >> 3, s = item & 7, b = bh / NH, h = bh % NH;
        for (int u = 0; u < 2; ++u) { int qb = u ? s : 15 - s; asm volatile("" : "+s"(qb));
            if (fast) attn_unit<true>(Q, KN, KR, VT, O, qhg, rope, msq, lds, b, h, qb, tid); else attn_unit<false>(Q, KN, KR, VT, O, qhg, rope, msq, lds, b, h, qb, tid); }
    }
}

constexpr int SG_PITCH = 272;
__device__ __forceinline__ void ph_sgu(CP p, int e, LAS unsigned char* lds) {
    const int tid = tidx(), lane = tid & 63, w = __builtin_amdgcn_readfirstlane(tid >> 6), fr = lane & 15, fq = lane >> 4;
    LAS unsigned char* Wl = lds; LAS unsigned char* Vl = lds + 128 * SG_PITCH; LAS float* rl = (LAS float*)(lds + 2 * 128 * SG_PITCH);
    const bf16* Gb = ws_bf(p, WS_U); bf16* AB = ws_bf(p, WS_AB);
    const int G = gridDim.x;
    for (int unit = blockIdx.x; unit < NB * (SEQ / 128) * NG; unit += G) {
        const int g = unit % NG, row0 = (unit / NG) * 128;
        __syncthreads();
        {
            const int s = tid >> 2, d0 = (tid & 3) * 32; const bf16* vsrc = Gb + (size_t)(row0 + s) * D + DA + g * GD + d0; float ss = 0.f;
#pragma unroll
            for (int c = 0; c < 4; ++c) { const u32x4 v = *(const u32x4*)(vsrc + 8 * c); const unsigned vv[4] = {v.x, v.y, v.z, v.w};
#pragma unroll
                for (int j = 0; j < 4; ++j) { const float a = bf_lo(vv[j]), b = bf_hi(vv[j]); ss += a * a + b * b;
                    *(LAS bf16*)(Vl + (d0 + 8 * c + 2 * j) * SG_PITCH + s * 2) = (bf16)(vv[j] & 0xffffu); *(LAS bf16*)(Vl + (d0 + 8 * c + 2 * j + 1) * SG_PITCH + s * 2) = (bf16)(vv[j] >> 16); } }
            ss += __shfl_xor(ss, 1); ss += __shfl_xor(ss, 2);
            if ((tid & 3) == 0) rl[s] = 1.0f / sqrtf(ss * (1.0f / GD) + EPS);
        }
        __syncthreads();
        {
            const int t = tid >> 2, s0 = (tid & 3) * 32; const float* wsrc = p.sgu_w + (((size_t)e * NG + g) * 128 + t) * 128 + s0;
#pragma unroll
            for (int c = 0; c < 4; ++c) { const f32x4 a = *(const f32x4*)(wsrc + 8 * c), b = *(const f32x4*)(wsrc + 8 * c + 4); const int s = s0 + 8 * c;
                const f32x4 ra = *(const LAS f32x4*)(rl + s), rb = *(const LAS f32x4*)(rl + s + 4);
                u32x4 o; o.x = pk2(s + 0 <= t ? a.x * ra.x : 0.f, s + 1 <= t ? a.y * ra.y : 0.f); o.y = pk2(s + 2 <= t ? a.z * ra.z : 0.f, s + 3 <= t ? a.w * ra.w : 0.f);
                o.z = pk2(s + 4 <= t ? b.x * rb.x : 0.f, s + 5 <= t ? b.y * rb.y : 0.f); o.w = pk2(s + 6 <= t ? b.z * rb.z : 0.f, s + 7 <= t ? b.w * rb.w : 0.f);
                *(LAS u32x4*)(Wl + t * SG_PITCH + s * 2) = o; }
        }
        __syncthreads();
        f32x4 acc[8];
#pragma unroll
        for (int db = 0; db < 8; ++db) acc[db] = (f32x4){0.f, 0.f, 0.f, 0.f};
        const int nks = (16 * w + 15) / 32 + 1;
        for (int ks = 0; ks < nks; ++ks) {
            const bf16x8 wf = *(const LAS bf16x8*)(Wl + (16 * w + fr) * SG_PITCH + (32 * ks + 8 * fq) * 2);
#pragma unroll
            for (int db = 0; db < 8; ++db) { const bf16x8 vf = *(const LAS bf16x8*)(Vl + (16 * db + fr) * SG_PITCH + (32 * ks + 8 * fq) * 2);
                acc[db] = __builtin_amdgcn_mfma_f32_16x16x32_bf16(vf, wf, acc[db], 0, 0, 0); }
        }
        const int t = 16 * w + fr; const float bs = p.sgu_b[((size_t)e * NG + g) * 128 + t];
        const float* gn = p.sgu_norm_g + (size_t)e * DA + g * GD;
        const size_t ro = (size_t)(row0 + t);
#pragma unroll
        for (int pq = 0; pq < 4; ++pq) {
            const f32x4 gg0 = *(const f32x4*)(gn + 32 * pq + 4 * fq), gg1 = *(const f32x4*)(gn + 32 * pq + 16 + 4 * fq);
            const f32x4 m0 = gg0 * acc[2 * pq] + bs, m1 = gg1 * acc[2 * pq + 1] + bs;
            const bool odd = (fq & 1) != 0; const f32x4 snd = odd ? m0 : m1; f32x4 rcv;
#pragma unroll
            for (int i = 0; i < 4; ++i) rcv[i] = __shfl_xor(snd[i], 16);
            const f32x4 lo = odd ? rcv : m0, hi4 = odd ? m1 : rcv;
            const int d = 16 * (2 * pq + (odd ? 1 : 0)) + 4 * (fq & 2);
            const u32x4 u = *(const u32x4*)(Gb + ro * D + g * GD + d);
            const u32x4 o = {pk2(bf_lo(u.x) * lo[0], bf_hi(u.x) * lo[1]), pk2(bf_lo(u.y) * lo[2], bf_hi(u.y) * lo[3]), pk2(bf_lo(u.z) * hi4[0], bf_hi(u.z) * hi4[1]), pk2(bf_lo(u.w) * hi4[2], bf_hi(u.w) * hi4[3])};
            *(u32x4*)(AB + ro * D + g * GD + d) = o; }
    }
}

__device__ __forceinline__ void ph_conv(CP p, int e, LAS unsigned char* lds) {
    const int tid = tidx();
    const bf16* Y = ws_bf(p, WS_Y); bf16* Z = ws_bf(p, WS_Z);
    const float* cw = p.conv_w + (size_t)e * CONVW * DA + 2 * tid; const f32x2 cb = *(const f32x2*)(p.conv_b + (size_t)e * DA + 2 * tid);
    f32x2 wv[CONVW];
#pragma unroll
    for (int j = 0; j < CONVW; ++j) wv[j] = *(const f32x2*)(cw + (size_t)j * DA);
    for (int unit = blockIdx.x; unit < M / 32; unit += gridDim.x) {
        const int row0 = unit * 32, t0 = row0 % SEQ;
        __syncthreads();
        for (int c = tid; c < 62 * 128; c += 512) { const int i = c >> 7, part = c & 127; const int tt = t0 - 30 + i;
            u32x4 v = {0u, 0u, 0u, 0u}; if (tt >= 0) v = *(const u32x4*)(Y + (size_t)(row0 - 30 + i) * DA + part * 8);
            *(LAS u32x4*)(lds + i * 2048 + part * 16) = v; }
        __syncthreads();
#pragma unroll 1
        for (int ob = 0; ob < 4; ++ob) {
            f32x2 win[38];
#pragma unroll
            for (int i = 0; i < 38; ++i) { const unsigned y = *(const LAS unsigned*)(lds + (8 * ob + i) * 2048 + tid * 4); win[i] = (f32x2){bf_lo(y), bf_hi(y)}; }
#pragma unroll
            for (int o = 0; o < 8; ++o) { f32x2 a = cb;
#pragma unroll
                for (int j = 0; j < CONVW; ++j) a += wv[j] * win[o + j];
                *(unsigned*)(Z + (size_t)(row0 + 8 * ob + o) * DA + 2 * tid) = pk2(a.x, a.y); }
        }
    }
}

#ifndef GEMM_REPS
#define GEMM_REPS 1
#endif
#ifndef WGM_DEF
#define WGM_DEF 4
#endif
#ifndef WGM_W1
#define WGM_W1 WGM_DEF
#endif
#ifndef WGM_W2
#define WGM_W2 8
#endif
#ifndef WGM_N2K
#define WGM_N2K WGM_DEF
#endif
#ifndef WGM_ABIN
#define WGM_ABIN 2
#endif
template <class Epi> __device__ __forceinline__ void run_gemm(LAS unsigned char* lds, const bf16* A, const bf16* Bt, int Mr, int N, int K, const Epi& E0, float* scratch = nullptr, int wgm = WGM_DEF) {
    pg8::Gemm g{A, Bt, Mr, N, K}; pg8::StaticOrder S; S.init(Mr, N, (int)gridDim.x, (int)blockIdx.x, wgm);
    Epi E = E0;
    if (scratch) E.redirect(scratch);
    pg8::gemm_phase<Epi, pg8::StaticOrder, PG8_ALIGN, PG8_SP2>(lds, g, S, E);
}

struct SubsetOrder : pg8::StaticOrder {
    bool active;
    __device__ void init2(int Mr, int N, int first, int count) { const int c = (int)blockIdx.x - first; active = (c >= 0 && c < count); init(Mr, N, count, active ? c : 0); }
    __device__ bool next(int i, pg8::Unit& u) const { return active && pg8::StaticOrder::next(i, u); }
};
template <class Epi> __device__ __forceinline__ void run_gemm_sub(LAS unsigned char* lds, const bf16* A, const bf16* Bt, int Mr, int N, int K, const Epi& E, int first, int count) {
    pg8::Gemm g{A, Bt, Mr, N, K}; SubsetOrder S; S.init2(Mr, N, first, count);
    pg8::gemm_phase<Epi, SubsetOrder, PG8_ALIGN, PG8_SP2>(lds, g, S, E);
}
constexpr int MLP_SPLIT = 2;
enum Phase { PH_PRO = 0, PH_MODFIN, PH_NORM1, PH_NORM2, PH_G_ABIN, PH_EVEN_POST, PH_SGU_CONV, PH_CONVLN, PH_G_ABOUT, PH_G_MLAIN, PH_MLA_MID, PH_G_QKV, PH_K_NORM, PH_ATTN, PH_G_MLAOUT, PH_G_W1, PH_G_W2 };

template <int PH> __device__ __forceinline__ void run_phase(CP p, int l, LAS unsigned char* lds, int rep = 0, int half = 0) {
    const int e = l >> 1;
    const float* xcur = (l == 0) ? p.x : ws_f32(p, WS_X);
    const float* mod = ws_f32(p, WS_MOD) + (size_t)l * NB * 6 * D;
    if constexpr (PH == PH_PRO) ph_prologue(p, lds);
    if constexpr (PH == PH_MODFIN) ph_modfin(p);
    if constexpr (PH == PH_NORM1) ph_norm(p, l, 0, p.x, (l == 0) ? nullptr : ws_bf(p, WS_X));
    if constexpr (PH == PH_NORM2) ph_norm(p, l, 1, p.x, ws_bf(p, WS_X));
    if constexpr (PH == PH_G_ABIN) { pg8::EpiEvenIn E{ws_bf(p, WS_U), ws_bf(p, WS_Y)}; run_gemm(lds, ws_bf(p, WS_H), ws_wt(p, WT_ABIN) + (size_t)e * DABIN * D, M, DABIN, D, E, nullptr, WGM_ABIN); }
    if constexpr (PH == PH_EVEN_POST) ph_even_post(p, e);
    if constexpr (PH == PH_SGU_CONV) { ph_sgu(p, e, lds); ph_conv(p, e, lds); }
    if constexpr (PH == PH_CONVLN) ph_convln(p, e);
    if constexpr (PH == PH_G_ABOUT) {
        const bf16* A = ws_bf(p, WS_AB); const bf16* Bt = ws_wt(p, WT_ABOUT) + (size_t)e * D * D; float* scr = rep ? ws_f32(p, WS_RAW) : nullptr;
        if (l == 0) { pg8::EpiResidB<true, false> E{p.x, ws_bf(p, WS_X), mod + 2 * D, D, 6 * D, SEQ}; run_gemm(lds, A, Bt, M, D, D, E, scr, WGM_N2K); }
        else { pg8::EpiResidB<false, false> E{ws_bf(p, WS_X), ws_bf(p, WS_X), mod + 2 * D, D, 6 * D, SEQ}; run_gemm(lds, A, Bt, M, D, D, E, scr, WGM_N2K); } }
    if constexpr (PH == PH_G_MLAIN) { pg8::EpiBf16SplitSsq E{ws_bf(p, WS_CQ), QR, QR, (size_t)(WS_CKV - WS_CQ) / 2, ws_f32(p, WS_MSQ)}; run_gemm(lds, ws_bf(p, WS_H), ws_wt(p, WT_MLAIN) + (size_t)e * DMLAINP * D, M, 2 * QR, D, E); }
    if constexpr (PH == PH_MLA_MID) ph_mla_mid(p, e);
    if constexpr (PH == PH_G_QKV) {
        const int G = (int)gridDim.x, nkr = G / 4;
        { pg8::EpiFirst64 E{ws_bf(p, WS_KR)}; run_gemm_sub(lds, ws_bf(p, WS_H), ws_wt(p, WT_MLAIN) + (size_t)e * DMLAINP * D + (size_t)2 * QR * D, M, 256, D, E, 0, nkr); }
        if ((int)blockIdx.x < nkr) {
            SubsetOrder S; S.init2(M, 256, 0, nkr); pg8::Unit u;
            for (int i = 0; S.next(i, u); ++i) kr_post(*kparams(), e, u.pm * 256);
            __syncthreads(); }
        { pg8::EpiBf16Plain E{ws_bf(p, WS_Q), NH * QKD}; run_gemm_sub(lds, ws_bf(p, WS_CQ), ws_wt(p, WT_UQ) + (size_t)e * NH * QKD * QR, M, NH * QKD, QR, E, nkr, G - nkr); }
        { pg8::EpiKNorm E{ws_bf(p, WS_KN), D, p.mla_k_head_g + (size_t)e * QKD, p.mla_q_head_g + (size_t)e * QKD, (LAS float*)(lds + LDS_SPARE), ws_f32(p, WS_MSQ)}; run_gemm(lds, ws_bf(p, WS_CKV), ws_wt(p, WT_UKV) + (size_t)e * 4096 * KVR, M, D, KVR, E); }
        { pg8::EpiVtScale E{ws_bf(p, WS_VT), M, ws_f32(p, WS_MSQ)}; run_gemm(lds, ws_wt(p, WT_UKV) + (size_t)e * 4096 * KVR + (size_t)2048 * KVR, ws_bf(p, WS_CKV), 2048, M, KVR, E); }
    }
    if constexpr (PH == PH_K_NORM) ph_k_norm(p, e);
    if constexpr (PH == PH_ATTN) ph_attn(p, e, lds);
    if constexpr (PH == PH_G_MLAOUT) { pg8::EpiResidB<false, false> E{ws_bf(p, WS_X), ws_bf(p, WS_X), mod + 2 * D, D, 6 * D, SEQ}; run_gemm(lds, ws_bf(p, WS_O), ws_wt(p, WT_MLAOUT) + (size_t)e * D * D, M, D, D, E, rep ? ws_f32(p, WS_RAW) : nullptr, WGM_N2K); }
    if constexpr (PH == PH_G_W1) { const size_t r0 = (size_t)half * (M / MLP_SPLIT);
        pg8::EpiRelu2 E{ws_bf(p, WS_HID) + r0 * DFF, DFF}; run_gemm(lds, ws_bf(p, WS_H) + r0 * D, ws_wt(p, WT_W1) + (size_t)l * DFF * D, M / MLP_SPLIT, DFF, D, E, nullptr, WGM_W1); }
    if constexpr (PH == PH_G_W2) { const size_t r0 = (size_t)half * (M / MLP_SPLIT);
        const bf16* A = ws_bf(p, WS_HID) + r0 * DFF; const bf16* Bt = ws_wt(p, WT_W2) + (size_t)l * D * DFF; const float* gt = mod + 5 * D + (size_t)(r0 / SEQ) * 6 * D; float* scr = rep ? ws_f32(p, WS_RAW) : nullptr;
        if (l == DEPTH - 1) { pg8::EpiResidB<false, true> E{ws_bf(p, WS_X) + r0 * D, p.out + r0 * D, gt, D, 6 * D, SEQ}; run_gemm(lds, A, Bt, M / MLP_SPLIT, D, DFF, E, scr, WGM_W2); }
        else { pg8::EpiResidB<false, false> E{ws_bf(p, WS_X) + r0 * D, ws_bf(p, WS_X) + r0 * D, gt, D, 6 * D, SEQ}; run_gemm(lds, A, Bt, M / MLP_SPLIT, D, DFF, E, scr, WGM_W2); } }
}

template <int PH> __global__ void __launch_bounds__(512, 2) k_phase(Params p, int l, int pad) {
    extern __shared__ __attribute__((aligned(16))) unsigned char lds_raw[];
    run_phase<PH>(*kparams(), l, (LAS unsigned char*)lds_raw);
}


__global__ void __launch_bounds__(512, 2) k_mega(Params p) {
    extern __shared__ __attribute__((aligned(16))) unsigned char lds_raw[];
    LAS unsigned char* lds = (LAS unsigned char*)lds_raw;
    volatile LAS unsigned* misc = (volatile LAS unsigned*)(lds + LDS_MISC);
    if (tidx() < 32) misc[tidx()] = 0u;
    __syncthreads();
    XcdBarrier bar = xcd_barrier_post((unsigned*)(kparams()->ws + WS_CTL) + CW_BAR, misc + 8);
#define GB() xcd_barrier(bar)
    run_phase<PH_PRO>(*kparams(), 0, lds); GB();
    run_phase<PH_MODFIN>(*kparams(), 0, lds); GB();
#pragma unroll
    for (int l = 0; l < DEPTH; ++l) {
        run_phase<PH_NORM1>(*kparams(), l, lds); GB();
        if ((l & 1) == 0) {
            run_phase<PH_G_ABIN>(*kparams(), l, lds); GB();
            run_phase<PH_SGU_CONV>(*kparams(), l, lds); GB();
            run_phase<PH_CONVLN>(*kparams(), l, lds); GB();
            run_phase<PH_G_ABOUT>(*kparams(), l, lds); GB();
        } else {
            run_phase<PH_G_MLAIN>(*kparams(), l, lds); GB();
            run_phase<PH_G_QKV>(*kparams(), l, lds); GB();
            run_phase<PH_ATTN>(*kparams(), l, lds); GB();
            run_phase<PH_G_MLAOUT>(*kparams(), l, lds); GB();
        }
        run_phase<PH_NORM2>(*kparams(), l, lds); GB();
        for (int hf = 0; hf < MLP_SPLIT; ++hf) {
            run_phase<PH_G_W1>(*kparams(), l, lds, 0, hf); GB();
            run_phase<PH_G_W2>(*kparams(), l, lds, 0, hf);
            if (hf == MLP_SPLIT - 1 && l != DEPTH - 1) GB();
        }
    }
#undef GB
}

template <int PH> static void launch_phase(const Params& p, int l, hipStream_t stream) {
    static bool attr_set = false;
    if (!attr_set) { (void)hipFuncSetAttribute((const void*)k_phase<PH>, hipFuncAttributeMaxDynamicSharedMemorySize, LDS_BYTES); attr_set = true; }
    hipLaunchKernelGGL(k_phase<PH>, dim3(256), dim3(512), LDS_BYTES, stream, p, l, 0);
}

extern "C" void kernel_launch(void* const* d_in, const int* in_sizes, int n_in, void* d_out, int out_size, void* d_ws, size_t ws_size, hipStream_t stream) {
    if (n_in != 25 || ws_size < WS_END) { fprintf(stderr, "kernel_launch: unexpected n_in %d / ws_size %zu (need %zu)\n", n_in, ws_size, (size_t)WS_END); return; }
    Params p; memset(&p, 0, sizeof(p));
    const float** pp = (const float**)&p;
    for (int i = 0; i < 25; ++i) pp[i] = (const float*)d_in[i];
    p.out = (float*)d_out; p.ws = (unsigned char*)d_ws;
    (void)hipMemsetAsync((char*)d_ws + WS_CTL + (size_t)CW_BAR * 4, 0, (size_t)XCD_BAR_WORDS * 4, stream);
#if MEGA
    static int grid = 0;
    if (!grid) {
        int dev = 0, cus = 0;
        (void)hipGetDevice(&dev); (void)hipDeviceGetAttribute(&cus, hipDeviceAttributeMultiprocessorCount, dev);
        (void)hipFuncSetAttribute((const void*)k_mega, hipFuncAttributeMaxDynamicSharedMemorySize, LDS_BYTES);
        grid = cus > 0 ? cus : 256;
    }
    hipLaunchKernelGGL(k_mega, dim3(grid), dim3(512), LDS_BYTES, stream, p);
#else
    launch_phase<PH_PRO>(p, 0, stream);
    launch_phase<PH_MODFIN>(p, 0, stream);
    for (int l = 0; l < DEPTH; ++l) {
        launch_phase<PH_NORM1>(p, l, stream);
        if ((l & 1) == 0) {
            launch_phase<PH_G_ABIN>(p, l, stream);
            launch_phase<PH_SGU_CONV>(p, l, stream);
            launch_phase<PH_CONVLN>(p, l, stream);
            launch_phase<PH_G_ABOUT>(p, l, stream);
        } else {
            launch_phase<PH_G_MLAIN>(p, l, stream);
            launch_phase<PH_G_QKV>(p, l, stream);
            launch_phase<PH_ATTN>(p, l, stream);
            launch_phase<PH_G_MLAOUT>(p, l, stream);
        }
        launch_phase<PH_NORM2>(p, l, stream);
        launch_phase<PH_G_W1>(p, l, stream);
        launch_phase<PH_G_W2>(p, l, stream);
    }
#endif
}
```

```cpp
#include <hip/hip_runtime.h>
#include <cstdio>
#include <cstdint>
#include <cstring>

#define GEMM_REPS 1
#ifndef MEGA
#define MEGA 1
#endif

constexpr int D = 2048, NB = 4, SEQ = 4096, M = NB * SEQ, DEPTH = 4, DFF = 8192;
constexpr int DA = 1024, NG = 8, GD = 128, CONVW = 31, DABIN = 4096;
constexpr int NH = 16, QR = 512, KVR = 512, NOPE = 128, ROPE = 64, VD = 128, QKD = 192, DMLAIN = 1088, DMLAINP = 1280;
constexpr float EPS = 1e-6f;
constexpr float QSCALE = 0.07216878364870322f * 1.4426950408889634f;

constexpr size_t MiB = 1u << 20;
constexpr size_t WS_CTL = 0, CTL_ZERO_BYTES = 2 * MiB;
constexpr size_t WS_MOD = 2 * MiB, WS_ROPE = 3 * MiB, WS_MODP = 4 * MiB;
constexpr size_t WS_WT = 32 * MiB;
constexpr size_t WT_ABIN = 0, WT_ABOUT = WT_ABIN + (size_t)2 * DABIN * D, WT_MLAIN = WT_ABOUT + (size_t)2 * D * D,
                 WT_UQ = WT_MLAIN + (size_t)2 * DMLAINP * D, WT_UKV = WT_UQ + (size_t)2 * NH * QKD * QR,
                 WT_MLAOUT = WT_UKV + (size_t)2 * 4096 * KVR, WT_W1 = WT_MLAOUT + (size_t)2 * D * D,
                 WT_W2 = WT_W1 + (size_t)DEPTH * DFF * D, WT_END = WT_W2 + (size_t)DEPTH * DFF * D;
static_assert(WS_WT + WT_END * 2 <= 384 * MiB, "weights fit");
constexpr size_t WS_X = 384 * MiB, WS_H = 512 * MiB, WS_HID = 576 * MiB;
constexpr size_t WS_U = 576 * MiB, WS_VN = 608 * MiB, WS_Y = 640 * MiB, WS_AB = 672 * MiB, WS_Z = 736 * MiB;
constexpr size_t WS_CQ = 576 * MiB, WS_CKV = 592 * MiB, WS_KR = 608 * MiB, WS_Q = 640 * MiB, WS_KN = 736 * MiB, WS_VT = 800 * MiB,
                 WS_V = 864 * MiB, WS_O = 928 * MiB, WS_MSQ = 612 * MiB;
constexpr size_t WS_RAW = 1024 * MiB, WS_END = 1280 * MiB;

constexpr int CW_BAR = 4096;

constexpr int LDS_BYTES = 147456;
constexpr int LDS_SPARE = 131072;
constexpr int LDS_MISC = LDS_SPARE + 12288;

#define LAS __attribute__((address_space(3)))
typedef unsigned short bf16;
typedef float f32x4 __attribute__((ext_vector_type(4)));
typedef float f32x2 __attribute__((ext_vector_type(2)));
typedef unsigned u32x4 __attribute__((ext_vector_type(4)));
typedef unsigned u32x2 __attribute__((ext_vector_type(2)));
typedef short bf16x8 __attribute__((ext_vector_type(8)));

__device__ __forceinline__ int tidx() { int t = threadIdx.x; asm volatile("" : "+v"(t)); return t; }
__device__ __forceinline__ unsigned f2bf(float f) { unsigned u = __builtin_bit_cast(unsigned, f); return (u + 0x7fffu + ((u >> 16) & 1u)) >> 16; }
__device__ __forceinline__ unsigned pk2(float lo, float hi) { return f2bf(lo) | (f2bf(hi) << 16); }
typedef __bf16 bf16x2_t __attribute__((ext_vector_type(2)));
__device__ __forceinline__ unsigned cvtpk(float lo, float hi) { f32x2 v = {lo, hi}; bf16x2_t b = __builtin_convertvector(v, bf16x2_t); return __builtin_bit_cast(unsigned, b); }
__device__ __forceinline__ float bf_lo(unsigned w) { return __builtin_bit_cast(float, w << 16); }
__device__ __forceinline__ float bf_hi(unsigned w) { return __builtin_bit_cast(float, w & 0xffff0000u); }
__device__ __forceinline__ float bf2f(bf16 b) { return __builtin_bit_cast(float, (unsigned)b << 16); }
__device__ __forceinline__ float wave_sum(float v) {
#pragma unroll
    for (int o = 1; o < 64; o <<= 1) v += __shfl_xor(v, o);
    return v;
}
__device__ __forceinline__ float wave_max(float v) {
#pragma unroll
    for (int o = 1; o < 64; o <<= 1) v = fmaxf(v, __shfl_xor(v, o));
    return v;
}
__device__ __forceinline__ float gelu_tanh(float x) {
    const float y = 0.7978845608028654f * (x + 0.044715f * x * x * x);
    return x / (1.f + __expf(-2.f * y));
}
__device__ __forceinline__ float sigmoidf_(float x) { return 1.f / (1.f + __expf(-x)); }

struct Params {
    const float *x, *c, *norm1_g, *norm2_g, *ada_w, *ada_b, *mlp_w1, *mlp_w2, *ab_w_in, *sgu_norm_g, *sgu_w, *sgu_b, *conv_w, *conv_b,
        *conv_ln_g, *conv_ln_b, *ab_w_out, *mla_w_in, *mla_q_norm_g, *mla_kv_norm_g, *mla_w_uq, *mla_w_ukv, *mla_q_head_g, *mla_k_head_g, *mla_w_out;
    float* out; unsigned char* ws;
};
typedef const __attribute__((address_space(4))) Params& CP;
typedef const __attribute__((address_space(4))) Params* CPP;
__device__ __forceinline__ CPP kparams() { CPP q = (CPP)__builtin_amdgcn_kernarg_segment_ptr(); asm volatile("" : "+s"(q)); return q; }
namespace pg8 {
#define PG8_LAS __attribute__((address_space(3)))
typedef unsigned short bf16_t;
typedef short bf16x8 __attribute__((ext_vector_type(8)));
typedef float f32x4 __attribute__((ext_vector_type(4)));
typedef unsigned u32x4 __attribute__((ext_vector_type(4)));
constexpr int BM = 256, BK = 64, HALF = 128, HTB = HALF * BK * 2  , STAGE_BYTES = 8 * HTB, NXCD = 8;

__host__ __device__ __forceinline__ int lds_byte(int r, int c) { const int st = (r >> 4) * 2 + (c >> 5), rr = r & 15, cc = c & 31, ob = rr * 64 + cc * 2; return st * 1024 + (ob ^ (((ob >> 9) & 1) << 5)); }
__host__ __device__ __forceinline__ void stage_rc(int b, int& R, int& C) { const int st = b / 1024, sb = b % 1024, swz = sb ^ (((sb >> 9) & 1) << 5); R = (st >> 1) * 16 + swz / 64; C = (st & 1) * 32 + (swz % 64) / 2; }
__host__ __device__ __forceinline__ int perm32(int rho) { const int n = rho >> 4, i = rho & 15; return 8 * (i >> 2) + 4 * n + (i & 3); }

struct Unit { int pm, pn; };
struct Gemm { const bf16_t* A; const bf16_t* Bt; int M, N, K; };

struct StaticOrder {
    int nM, nN, nwg, G, c, WGM;
    __host__ __device__ void init(int M, int N, int G_, int c_, int wgm = 4) { nM = M / BM; nN = N / BM; nwg = nM * nN; G = G_; c = c_; WGM = wgm; }
    __host__ __device__ bool next(int i, Unit& u) const {
        const long L = (long)i * G + c; if (L >= nwg) return false;
        int wgid = (int)L; { const int q = nwg / NXCD, r = nwg % NXCD, xcd = wgid % NXCD, off = wgid / NXCD; wgid = (xcd < r ? xcd * (q + 1) : r * (q + 1) + (xcd - r) * q) + off; }
        const int nig = WGM * nN, gid = wgid / nig, fm = gid * WGM, gsz = (nM - fm) < WGM ? (nM - fm) : WGM;
        u.pm = fm + ((wgid % nig) % gsz); u.pn = (wgid % nig) / gsz; return true;
    }
    __device__ __forceinline__ void a_ready(const Unit&) const {}
    __device__ __forceinline__ void done(const Unit&) const {}
};
__device__ __forceinline__ unsigned cvt_pk_bf16(float lo, float hi) { unsigned r; asm volatile("v_cvt_pk_bf16_f32 %0, %1, %2" : "=v"(r) : "v"(lo), "v"(hi)); return r; }

struct EpiF32 {
    static constexpr bool PERM = false, AFTER_DRAIN = false;
    float* C; int ldc;
    __device__ __forceinline__ void redirect(float*) {}
    __device__ __forceinline__ void operator()(f32x4 (&acc)[2][2][4][2], const Unit& u, int wr, int wc, int fr, int fq) const {
        const int row0 = u.pm * BM + wr * 64 + fr, col0 = u.pn * BM + wc * 32 + 4 * fq;
#pragma unroll
        for (int ai = 0; ai < 2; ++ai)
#pragma unroll
            for (int m = 0; m < 4; ++m) { float* rowp = C + (size_t)(row0 + ai * HALF + m * 16) * ldc + col0;
#pragma unroll
                for (int bj = 0; bj < 2; ++bj)
#pragma unroll
                    for (int n = 0; n < 2; ++n) *(f32x4*)(rowp + bj * HALF + n * 16) = acc[ai][bj][m][n]; }
    }
};
struct EpiRelu2 {
    static constexpr bool PERM = true, AFTER_DRAIN = false;
    bf16_t* O; int ldc;
    __device__ __forceinline__ void redirect(float*) {}
    __device__ __forceinline__ void operator()(f32x4 (&acc)[2][2][4][2], const Unit& u, int wr, int wc, int fr, int fq) const {
        const int row0 = u.pm * BM + wr * 64 + fr, col0 = u.pn * BM + wc * 32 + 8 * fq;
#pragma unroll
        for (int ai = 0; ai < 2; ++ai)
#pragma unroll
            for (int m = 0; m < 4; ++m) { bf16_t* rowp = O + (size_t)(row0 + ai * HALF + m * 16) * ldc + col0;
#pragma unroll
                for (int bj = 0; bj < 2; ++bj) { f32x4 v0 = acc[ai][bj][m][0], v1 = acc[ai][bj][m][1];
#pragma unroll
                    for (int j = 0; j < 4; ++j) { const float a = fmaxf(v0[j], 0.f), b = fmaxf(v1[j], 0.f); v0[j] = a * a; v1[j] = b * b; }
                    u32x4 w; w.x = cvt_pk_bf16(v0[0], v0[1]); w.y = cvt_pk_bf16(v0[2], v0[3]); w.z = cvt_pk_bf16(v1[0], v1[1]); w.w = cvt_pk_bf16(v1[2], v1[3]);
                    *(u32x4*)(rowp + bj * HALF) = w; } }
    }
};
struct EpiResid {
    static constexpr bool PERM = false, AFTER_DRAIN = false;
    const float* xold; float* xnew; const float* gate; int ldc; int gate_bstride; int rows_per_batch;
    __device__ __forceinline__ void redirect(float* s) { xnew = s; }
    __device__ __forceinline__ void operator()(f32x4 (&acc)[2][2][4][2], const Unit& u, int wr, int wc, int fr, int fq) const {
        const int row0 = u.pm * BM + wr * 64 + fr, col0 = u.pn * BM + wc * 32 + 4 * fq;
        const float* gp = gate + (size_t)((u.pm * BM) / rows_per_batch) * gate_bstride + col0;
        f32x4 gv[2][2];
#pragma unroll
        for (int bj = 0; bj < 2; ++bj)
#pragma unroll
            for (int n = 0; n < 2; ++n) gv[bj][n] = *(const f32x4*)(gp + bj * HALF + n * 16);
#pragma unroll
        for (int ai = 0; ai < 2; ++ai)
#pragma unroll
            for (int m = 0; m < 4; ++m) { const size_t off = (size_t)(row0 + ai * HALF + m * 16) * ldc + col0;
#pragma unroll
                for (int bj = 0; bj < 2; ++bj)
#pragma unroll
                    for (int n = 0; n < 2; ++n) { const f32x4 xo = *(const f32x4*)(xold + off + bj * HALF + n * 16);
                        *(f32x4*)(xnew + off + bj * HALF + n * 16) = xo + gv[bj][n] * acc[ai][bj][m][n]; } }
    }
};
template <bool IN_F32, bool OUT_F32> struct EpiResidB {
    static constexpr bool PERM = true, AFTER_DRAIN = false;
    const void* xold; void* xnew; const float* gate; int ldc; int gate_bstride; int rows_per_batch;
    __device__ __forceinline__ void redirect(float* s) { xnew = s; }
    __device__ __forceinline__ void operator()(f32x4 (&acc)[2][2][4][2], const Unit& u, int wr, int wc, int fr, int fq) const {
        const int row0 = u.pm * BM + wr * 64 + fr, col0 = u.pn * BM + wc * 32 + 8 * fq;
        const float* gp = gate + (size_t)((u.pm * BM) / rows_per_batch) * gate_bstride + col0;
        f32x4 gv[2][2];
#pragma unroll
        for (int bj = 0; bj < 2; ++bj)
#pragma unroll
            for (int n = 0; n < 2; ++n) gv[bj][n] = *(const f32x4*)(gp + bj * HALF + 4 * n);
        if constexpr (IN_F32) {
#pragma unroll
            for (int am = 0; am < 4; ++am) { const int ai = am >> 1, m0 = 2 * (am & 1); f32x4 xf[4][2][2];
#pragma unroll
                for (int m = m0; m < m0 + 2; ++m)
#pragma unroll
                    for (int bj = 0; bj < 2; ++bj) { const float* xp = (const float*)xold + (size_t)(row0 + ai * HALF + m * 16) * ldc + col0 + bj * HALF; xf[m][bj][0] = *(const f32x4*)xp; xf[m][bj][1] = *(const f32x4*)(xp + 4); }
#pragma unroll
                for (int m = m0; m < m0 + 2; ++m)
#pragma unroll
                    for (int bj = 0; bj < 2; ++bj) { const size_t off = (size_t)(row0 + ai * HALF + m * 16) * ldc + col0 + bj * HALF;
                        const f32x4 x0 = xf[m][bj][0] + gv[bj][0] * acc[ai][bj][m][0], x1 = xf[m][bj][1] + gv[bj][1] * acc[ai][bj][m][1];
                        if constexpr (OUT_F32) { float* op = (float*)xnew + off; *(f32x4*)op = x0; *(f32x4*)(op + 4) = x1; }
                        else { u32x4 w; w.x = cvt_pk_bf16(x0[0], x0[1]); w.y = cvt_pk_bf16(x0[2], x0[3]); w.z = cvt_pk_bf16(x1[0], x1[1]); w.w = cvt_pk_bf16(x1[2], x1[3]); *(u32x4*)((bf16_t*)xnew + off) = w; } } }
        } else {
#pragma unroll
            for (int ai = 0; ai < 2; ++ai) { u32x4 xw[4][2];
#pragma unroll
                for (int m = 0; m < 4; ++m)
#pragma unroll
                    for (int bj = 0; bj < 2; ++bj) xw[m][bj] = *(const u32x4*)((const bf16_t*)xold + (size_t)(row0 + ai * HALF + m * 16) * ldc + col0 + bj * HALF);
#pragma unroll
                for (int m = 0; m < 4; ++m)
#pragma unroll
                    for (int bj = 0; bj < 2; ++bj) { const size_t off = (size_t)(row0 + ai * HALF + m * 16) * ldc + col0 + bj * HALF; const u32x4 w = xw[m][bj];
                        f32x4 x0 = (f32x4){__builtin_bit_cast(float, w.x << 16), __builtin_bit_cast(float, w.x & 0xffff0000u), __builtin_bit_cast(float, w.y << 16), __builtin_bit_cast(float, w.y & 0xffff0000u)};
                        f32x4 x1 = (f32x4){__builtin_bit_cast(float, w.z << 16), __builtin_bit_cast(float, w.z & 0xffff0000u), __builtin_bit_cast(float, w.w << 16), __builtin_bit_cast(float, w.w & 0xffff0000u)};
                        x0 = x0 + gv[bj][0] * acc[ai][bj][m][0]; x1 = x1 + gv[bj][1] * acc[ai][bj][m][1];
                        if constexpr (OUT_F32) { float* op = (float*)xnew + off; *(f32x4*)op = x0; *(f32x4*)(op + 4) = x1; }
                        else { u32x4 wo; wo.x = cvt_pk_bf16(x0[0], x0[1]); wo.y = cvt_pk_bf16(x0[2], x0[3]); wo.z = cvt_pk_bf16(x1[0], x1[1]); wo.w = cvt_pk_bf16(x1[2], x1[3]); *(u32x4*)((bf16_t*)xnew + off) = wo; } } }
        }
    }
};
struct EpiBf16Plain {
    static constexpr bool PERM = true, AFTER_DRAIN = false;
    bf16_t* O; int ldc;
    __device__ __forceinline__ void redirect(float*) {}
    __device__ __forceinline__ void operator()(f32x4 (&acc)[2][2][4][2], const Unit& u, int wr, int wc, int fr, int fq) const {
        const int row0 = u.pm * BM + wr * 64 + fr, col0 = u.pn * BM + wc * 32 + 8 * fq;
#pragma unroll
        for (int ai = 0; ai < 2; ++ai)
#pragma unroll
            for (int m = 0; m < 4; ++m) { bf16_t* rowp = O + (size_t)(row0 + ai * HALF + m * 16) * ldc + col0;
#pragma unroll
                for (int bj = 0; bj < 2; ++bj) { const f32x4 v0 = acc[ai][bj][m][0], v1 = acc[ai][bj][m][1];
                    u32x4 w; w.x = cvt_pk_bf16(v0[0], v0[1]); w.y = cvt_pk_bf16(v0[2], v0[3]); w.z = cvt_pk_bf16(v1[0], v1[1]); w.w = cvt_pk_bf16(v1[2], v1[3]);
                    *(u32x4*)(rowp + bj * HALF) = w; } }
    }
};
__device__ __forceinline__ float msq_kv(const float* P, size_t row) { const f32x4 a = *(const f32x4*)(P + row * 16 + 8), b = *(const f32x4*)(P + row * 16 + 12); return (((a[0] + a[1]) + (a[2] + a[3])) + ((b[0] + b[1]) + (b[2] + b[3]))) * (1.0f / 512.0f); }
struct EpiKNorm {
    static constexpr bool PERM = true, AFTER_DRAIN = false;
    bf16_t* O; int ldc; const float* kg; const float* qg; PG8_LAS float* xch; const float* P;
    __device__ __forceinline__ void redirect(float*) {}
    __device__ __forceinline__ void operator()(f32x4 (&acc)[2][2][4][2], const Unit& u, int wr, int wc, int fr, int fq) const {
        const int row0 = u.pm * BM + wr * 64 + fr, col0 = u.pn * BM + wc * 32 + 8 * fq;
        PG8_LAS float* xw = xch + (wr * 16 * 16 + fr) * 4;
#pragma unroll
        for (int ai = 0; ai < 2; ++ai)
#pragma unroll
            for (int m = 0; m < 4; ++m)
#pragma unroll
                for (int bj = 0; bj < 2; ++bj) { const f32x4 v0 = acc[ai][bj][m][0], v1 = acc[ai][bj][m][1];
                    float ss = (v0[0] * v0[0] + v0[1] * v0[1]) + (v0[2] * v0[2] + v0[3] * v0[3]) + (v1[0] * v1[0] + v1[1] * v1[1]) + (v1[2] * v1[2] + v1[3] * v1[3]);
                    ss += __shfl_xor(ss, 16); ss += __shfl_xor(ss, 32);
                    if (fq == 0) xw[(((ai * 4 + m) * 2 + bj) * 16) * 4 + wc] = ss; }
        float epsr[2][4];
#pragma unroll
        for (int ai = 0; ai < 2; ++ai)
#pragma unroll
            for (int m = 0; m < 4; ++m) epsr[ai][m] = 1e-6f * (msq_kv(P, (size_t)(row0 + ai * HALF + m * 16)) + 1e-6f);
        asm volatile("s_waitcnt lgkmcnt(0)" ::: "memory"); __builtin_amdgcn_s_barrier(); asm volatile("" ::: "memory");
        const f32x4 g0 = *(const f32x4*)(kg + wc * 32 + 8 * fq) * *(const f32x4*)(qg + wc * 32 + 8 * fq), g1 = *(const f32x4*)(kg + wc * 32 + 8 * fq + 4) * *(const f32x4*)(qg + wc * 32 + 8 * fq + 4);
#pragma unroll
        for (int ai = 0; ai < 2; ++ai)
#pragma unroll
            for (int m = 0; m < 4; ++m) { bf16_t* rowp = O + (size_t)(row0 + ai * HALF + m * 16) * ldc + col0;
#pragma unroll
                for (int bj = 0; bj < 2; ++bj) { const f32x4 q4 = *(const PG8_LAS f32x4*)(xw + (((ai * 4 + m) * 2 + bj) * 16) * 4);
                    const float rk = __builtin_amdgcn_rsqf(((q4[0] + q4[1]) + (q4[2] + q4[3])) * (1.0f / 128.0f) + epsr[ai][m]);
                    const f32x4 v0 = acc[ai][bj][m][0] * rk * g0, v1 = acc[ai][bj][m][1] * rk * g1;
                    u32x4 w; w.x = cvt_pk_bf16(v0[0], v0[1]); w.y = cvt_pk_bf16(v0[2], v0[3]); w.z = cvt_pk_bf16(v1[0], v1[1]); w.w = cvt_pk_bf16(v1[2], v1[3]);
                    *(u32x4*)(rowp + bj * HALF) = w; } }
    }
};
__device__ __forceinline__ float gelu_t(float x) { const float y = x * (-2.302208198f - 0.10294324f * x * x); return x * __builtin_amdgcn_rcpf(1.f + __builtin_amdgcn_exp2f(y)); }
__device__ __forceinline__ float sigm_t(float g) { return __builtin_amdgcn_rcpf(1.f + __builtin_amdgcn_exp2f(-1.4426950408889634f * g)); }
struct EpiEvenIn {
    static constexpr bool PERM = true, AFTER_DRAIN = false;
    bf16_t *G, *Y;
    __device__ __forceinline__ void redirect(float*) {}
    __device__ __forceinline__ void operator()(f32x4 (&acc)[2][2][4][2], const Unit& u, int wr, int wc, int fr, int fq) const {
        const int row0 = u.pm * BM + wr * 64 + fr, tcol = wc * 32 + 8 * fq;
        if (u.pn < 8) {
#pragma unroll
            for (int ai = 0; ai < 2; ++ai)
#pragma unroll
                for (int m = 0; m < 4; ++m) { bf16_t* rowp = G + (size_t)(row0 + ai * HALF + m * 16) * 2048 + u.pn * BM + tcol;
#pragma unroll
                    for (int bj = 0; bj < 2; ++bj) { const f32x4 v0 = acc[ai][bj][m][0], v1 = acc[ai][bj][m][1];
                        u32x4 w; w.x = cvt_pk_bf16(gelu_t(v0[0]), gelu_t(v0[1])); w.y = cvt_pk_bf16(gelu_t(v0[2]), gelu_t(v0[3])); w.z = cvt_pk_bf16(gelu_t(v1[0]), gelu_t(v1[1])); w.w = cvt_pk_bf16(gelu_t(v1[2]), gelu_t(v1[3]));
                        *(u32x4*)(rowp + bj * HALF) = w; } }
        } else {
#pragma unroll
            for (int ai = 0; ai < 2; ++ai)
#pragma unroll
                for (int m = 0; m < 4; ++m) { bf16_t* rowp = Y + (size_t)(row0 + ai * HALF + m * 16) * 1024 + (u.pn - 8) * HALF + tcol;
                    f32x4 v0 = acc[ai][0][m][0], v1 = acc[ai][0][m][1]; const f32x4 g0 = acc[ai][1][m][0], g1 = acc[ai][1][m][1];
#pragma unroll
                    for (int j = 0; j < 4; ++j) { v0[j] = v0[j] * sigm_t(g0[j]); v1[j] = v1[j] * sigm_t(g1[j]); }
                    u32x4 w; w.x = cvt_pk_bf16(v0[0], v0[1]); w.y = cvt_pk_bf16(v0[2], v0[3]); w.z = cvt_pk_bf16(v1[0], v1[1]); w.w = cvt_pk_bf16(v1[2], v1[3]);
                    *(u32x4*)(rowp) = w; }
        }
    }
};
struct EpiBf16Split {
    static constexpr bool PERM = true, AFTER_DRAIN = false;
    bf16_t* O; int ldc; int split_cols; size_t split_stride;
    __device__ __forceinline__ void redirect(float*) {}
    __device__ __forceinline__ void operator()(f32x4 (&acc)[2][2][4][2], const Unit& u, int wr, int wc, int fr, int fq) const {
        const int row0 = u.pm * BM + wr * 64 + fr; int colt = u.pn * BM; const int t = colt / split_cols; colt -= t * split_cols;
        bf16_t* base = O + (size_t)t * split_stride + colt + wc * 32 + 8 * fq;
#pragma unroll
        for (int ai = 0; ai < 2; ++ai)
#pragma unroll
            for (int m = 0; m < 4; ++m) { bf16_t* rowp = base + (size_t)(row0 + ai * HALF + m * 16) * ldc;
#pragma unroll
                for (int bj = 0; bj < 2; ++bj) { const f32x4 v0 = acc[ai][bj][m][0], v1 = acc[ai][bj][m][1];
                    u32x4 w; w.x = cvt_pk_bf16(v0[0], v0[1]); w.y = cvt_pk_bf16(v0[2], v0[3]); w.z = cvt_pk_bf16(v1[0], v1[1]); w.w = cvt_pk_bf16(v1[2], v1[3]);
                    *(u32x4*)(rowp + bj * HALF) = w; } }
    }
};
struct EpiBf16SplitSsq {
    static constexpr bool PERM = true, AFTER_DRAIN = false;
    bf16_t* O; int ldc; int split_cols; size_t split_stride; float* P;
    __device__ __forceinline__ void redirect(float*) {}
    __device__ __forceinline__ void operator()(f32x4 (&acc)[2][2][4][2], const Unit& u, int wr, int wc, int fr, int fq) const {
        const int row0 = u.pm * BM + wr * 64 + fr; int colt = u.pn * BM; const int t = colt / split_cols; colt -= t * split_cols;
        bf16_t* base = O + (size_t)t * split_stride + colt + wc * 32 + 8 * fq;
#pragma unroll
        for (int ai = 0; ai < 2; ++ai)
#pragma unroll
            for (int m = 0; m < 4; ++m) { bf16_t* rowp = base + (size_t)(row0 + ai * HALF + m * 16) * ldc; float ss = 0.f;
#pragma unroll
                for (int bj = 0; bj < 2; ++bj) { const f32x4 v0 = acc[ai][bj][m][0], v1 = acc[ai][bj][m][1];
                    ss += (v0[0] * v0[0] + v0[1] * v0[1]) + (v0[2] * v0[2] + v0[3] * v0[3]) + (v1[0] * v1[0] + v1[1] * v1[1]) + (v1[2] * v1[2] + v1[3] * v1[3]);
                    u32x4 w; w.x = cvt_pk_bf16(v0[0], v0[1]); w.y = cvt_pk_bf16(v0[2], v0[3]); w.z = cvt_pk_bf16(v1[0], v1[1]); w.w = cvt_pk_bf16(v1[2], v1[3]);
                    *(u32x4*)(rowp + bj * HALF) = w; }
                ss += __shfl_xor(ss, 16); ss += __shfl_xor(ss, 32);
                if (fq == 0) P[(size_t)(row0 + ai * HALF + m * 16) * 16 + u.pn * 4 + wc] = ss; }
    }
};
struct EpiVtScale {
    static constexpr bool PERM = true, AFTER_DRAIN = false;
    bf16_t* O; int ldc; const float* P;
    __device__ __forceinline__ void redirect(float*) {}
    __device__ __forceinline__ void operator()(f32x4 (&acc)[2][2][4][2], const Unit& u, int wr, int wc, int fr, int fq) const {
        const int row0 = u.pm * BM + wr * 64 + fr, col0 = u.pn * BM + wc * 32 + 8 * fq;
        f32x4 sc[2][2];
#pragma unroll
        for (int bj = 0; bj < 2; ++bj)
#pragma unroll
            for (int j = 0; j < 8; ++j) sc[bj][j >> 2][j & 3] = __builtin_amdgcn_rsqf(msq_kv(P, (size_t)(col0 + bj * HALF + j)) + 1e-6f);
#pragma unroll
        for (int ai = 0; ai < 2; ++ai)
#pragma unroll
            for (int m = 0; m < 4; ++m) { bf16_t* rowp = O + (size_t)(row0 + ai * HALF + m * 16) * ldc + col0;
#pragma unroll
                for (int bj = 0; bj < 2; ++bj) { const f32x4 v0 = acc[ai][bj][m][0] * sc[bj][0], v1 = acc[ai][bj][m][1] * sc[bj][1];
                    u32x4 w; w.x = cvt_pk_bf16(v0[0], v0[1]); w.y = cvt_pk_bf16(v0[2], v0[3]); w.z = cvt_pk_bf16(v1[0], v1[1]); w.w = cvt_pk_bf16(v1[2], v1[3]);
                    *(u32x4*)(rowp + bj * HALF) = w; } }
    }
};
struct EpiFirst64 {
    static constexpr bool PERM = true, AFTER_DRAIN = false;
    bf16_t* O;
    __device__ __forceinline__ void redirect(float*) {}
    __device__ __forceinline__ void operator()(f32x4 (&acc)[2][2][4][2], const Unit& u, int wr, int wc, int fr, int fq) const {
        if (wc < 2) {
            const int row0 = u.pm * BM + wr * 64 + fr;
#pragma unroll
            for (int ai = 0; ai < 2; ++ai)
#pragma unroll
                for (int m = 0; m < 4; ++m) { const f32x4 v0 = acc[ai][0][m][0], v1 = acc[ai][0][m][1];
                    u32x4 w; w.x = cvt_pk_bf16(v0[0], v0[1]); w.y = cvt_pk_bf16(v0[2], v0[3]); w.z = cvt_pk_bf16(v1[0], v1[1]); w.w = cvt_pk_bf16(v1[2], v1[3]);
                    *(u32x4*)(O + (size_t)(row0 + ai * HALF + m * 16) * 64 + wc * 32 + 8 * fq) = w; }
        }
    }
};
template <class Epi, class Sched, bool ALIGN_EPI = false, bool SP2 = false>
__device__ __forceinline__ void gemm_phase(PG8_LAS unsigned char* lds, const Gemm g, const Sched& S, const Epi& E) {
    const int tid = tidx(), wid = __builtin_amdgcn_readfirstlane(tid >> 6), lane = tid & 63, wr = wid >> 2, wc = wid & 3, fr = lane & 15, fq = lane >> 4;
    const int K = g.K, nt = K / BK;
    unsigned voffA[2], voffB[2];
#pragma unroll
    for (int i = 0; i < 2; ++i) { int R, C; stage_rc(tid * 16 + i * 8192, R, C); const int Rb = Epi::PERM ? ((R & ~31) + perm32(R & 31)) : R;
        voffA[i] = (unsigned)(R * K + C) * 2u; voffB[i] = (unsigned)(Rb * K + C) * 2u; }
    const unsigned kstep = (unsigned)(BK * 2);
    const unsigned hstep = (unsigned)HALF * (unsigned)K * 2u;
    const unsigned tstep = 2u * hstep;
    const __amdgpu_buffer_rsrc_t rs_voffA = __builtin_amdgcn_make_buffer_rsrc((void*)g.A, (short)0, 0x7ffffff0, 0x00020000);
    const __amdgpu_buffer_rsrc_t rs_voffB = __builtin_amdgcn_make_buffer_rsrc((void*)g.Bt, (short)0, 0x7ffffff0, 0x00020000);
    const unsigned ldsw = (unsigned)wid * 1024u;
    const int aoff = lds_byte(wr * 64 + fr, fq * 8), boff = lds_byte(wc * 32 + fr, fq * 8);
#define PG8_SA(b, h) (((b) * 2 + (h)) * HTB)
#define PG8_SB(b, h) ((4 + (b) * 2 + (h)) * HTB)
#define PG8_STAGE(bufoff, gbase, voff) do { _Pragma("unroll") for (int _i = 0; _i < 2; ++_i) \
        __builtin_amdgcn_raw_ptr_buffer_load_lds(rs_##voff, (PG8_LAS void*)(lds + (bufoff) + ldsw + _i * 8192), 16, (voff)[_i], (gbase), 0, 0); } while (0)
#define PG8_LDA(dst, b, h) do { _Pragma("unroll") for (int m = 0; m < 4; ++m) _Pragma("unroll") for (int k = 0; k < 2; ++k) dst[m][k] = *(const PG8_LAS bf16x8*)(lds + PG8_SA(b, h) + aoff + m * 2048 + k * 1024); } while (0)
#define PG8_LDB(dst, b, h) do { _Pragma("unroll") for (int n = 0; n < 2; ++n) _Pragma("unroll") for (int k = 0; k < 2; ++k) dst[n][k] = *(const PG8_LAS bf16x8*)(lds + PG8_SB(b, h) + boff + n * 2048 + k * 1024); } while (0)
#define PG8_MMA(ai, bj, At, Bt) do { __builtin_amdgcn_s_setprio(1); _Pragma("unroll") for (int m = 0; m < 4; ++m) _Pragma("unroll") for (int n = 0; n < 2; ++n) _Pragma("unroll") for (int k = 0; k < 2; ++k) \
        acc[ai][bj][m][n] = __builtin_amdgcn_mfma_f32_16x16x32_bf16(Bt[n][k], At[m][k], acc[ai][bj][m][n], 0, 0, 0); __builtin_amdgcn_s_setprio(0); } while (0)
#define PG8_WAIT_V(n) asm volatile("s_waitcnt vmcnt(" #n ")" ::: "memory")
#define PG8_WAIT_L(n) asm volatile("s_waitcnt lgkmcnt(" #n ")" ::: "memory")
#define PG8_BAR __builtin_amdgcn_s_barrier()
#define PG8_SCHED __builtin_amdgcn_sched_barrier(0)
    Unit cur, nxt; int ui = 0;
    if (!S.next(0, cur)) return;
    f32x4 acc[2][2][4][2];
#pragma unroll
    for (int a = 0; a < 2; ++a)
#pragma unroll
        for (int b = 0; b < 2; ++b)
#pragma unroll
            for (int m = 0; m < 4; ++m)
#pragma unroll
                for (int n = 0; n < 2; ++n) acc[a][b][m][n] = (f32x4){0.f, 0.f, 0.f, 0.f};
    bf16x8 At[4][2], B0[2][2], B1[2][2];
    unsigned cA = (unsigned)cur.pm * tstep, cB = (unsigned)cur.pn * tstep;
    S.a_ready(cur);
    if constexpr (SP2) {
        PG8_STAGE(PG8_SB(0, 0), cB, voffB); PG8_STAGE(PG8_SB(0, 1), cB + hstep, voffB); PG8_STAGE(PG8_SA(0, 0), cA, voffA); PG8_STAGE(PG8_SA(0, 1), cA + hstep, voffA);
        if (wr == 1) PG8_BAR;
        PG8_WAIT_V(2); PG8_BAR;
        PG8_STAGE(PG8_SB(1, 0), cB + kstep, voffB); PG8_STAGE(PG8_SA(1, 0), cA + kstep, voffA); PG8_STAGE(PG8_SB(1, 1), cB + hstep + kstep, voffB);
        PG8_WAIT_V(6); PG8_BAR;
    } else {
        PG8_STAGE(PG8_SB(0, 0), cB, voffB); PG8_STAGE(PG8_SA(0, 0), cA, voffA); PG8_STAGE(PG8_SB(0, 1), cB + hstep, voffB); PG8_STAGE(PG8_SA(0, 1), cA + hstep, voffA);
        if (wr == 1) PG8_BAR;
        PG8_WAIT_V(4); PG8_BAR;
        PG8_STAGE(PG8_SB(1, 0), cB + kstep, voffB); PG8_STAGE(PG8_SA(1, 0), cA + kstep, voffA); PG8_STAGE(PG8_SB(1, 1), cB + hstep + kstep, voffB);
        PG8_WAIT_V(6); PG8_BAR;
    }
    for (;;) {
        const bool has_next = S.next(ui + 1, nxt);
        const unsigned nA = has_next ? (unsigned)nxt.pm * tstep : cA, nB = has_next ? (unsigned)nxt.pn * tstep : cB;
        for (int t = 0; t < nt; t += 2) {
            const bool last = (t == nt - 2);
            const unsigned a1 = cA + (unsigned)(t + 1) * kstep;
            const unsigned a2 = last ? nA : cA + (unsigned)(t + 2) * kstep, b2 = last ? nB : cB + (unsigned)(t + 2) * kstep;
            const unsigned a3 = a2 + kstep, b3 = b2 + kstep;
            if (last && has_next) S.a_ready(nxt);
            if constexpr (SP2) {
            PG8_LDB(B0, 0, 0); PG8_LDB(B1, 0, 1); PG8_SCHED; PG8_LDA(At, 0, 0); PG8_STAGE(PG8_SA(1, 1), a1 + hstep, voffA);
            PG8_WAIT_V(8); PG8_WAIT_L(0); PG8_BAR; PG8_MMA(0, 0, At, B0); PG8_MMA(0, 1, At, B1); PG8_BAR; PG8_SCHED;
            PG8_LDA(At, 0, 1); PG8_STAGE(PG8_SB(0, 0), b2, voffB); PG8_STAGE(PG8_SB(0, 1), b2 + hstep, voffB); PG8_STAGE(PG8_SA(0, 0), a2, voffA);
            PG8_WAIT_V(8); PG8_WAIT_L(0); PG8_BAR; PG8_MMA(1, 0, At, B0); PG8_MMA(1, 1, At, B1); PG8_BAR; PG8_SCHED;
            PG8_LDB(B0, 1, 0); PG8_LDB(B1, 1, 1); PG8_SCHED; PG8_LDA(At, 1, 0); PG8_STAGE(PG8_SA(0, 1), a2 + hstep, voffA);
            PG8_WAIT_V(8); PG8_WAIT_L(0); PG8_BAR; PG8_MMA(0, 0, At, B0); PG8_MMA(0, 1, At, B1); PG8_BAR; PG8_SCHED;
            PG8_LDA(At, 1, 1); PG8_STAGE(PG8_SB(1, 0), b3, voffB); PG8_STAGE(PG8_SB(1, 1), b3 + hstep, voffB); PG8_STAGE(PG8_SA(1, 0), a3, voffA);
            PG8_WAIT_V(8); PG8_WAIT_L(0); PG8_BAR; PG8_MMA(1, 0, At, B0); PG8_MMA(1, 1, At, B1); PG8_BAR; PG8_SCHED;
            } else {
            PG8_LDB(B0, 0, 0); PG8_SCHED; PG8_LDA(At, 0, 0); PG8_STAGE(PG8_SA(1, 1), a1 + hstep, voffA);
            PG8_WAIT_L(8); PG8_BAR; PG8_WAIT_L(0); PG8_MMA(0, 0, At, B0); PG8_BAR; PG8_SCHED;
            PG8_LDB(B1, 0, 1); PG8_STAGE(PG8_SB(0, 0), b2, voffB);
            PG8_BAR; PG8_WAIT_L(0); PG8_MMA(0, 1, At, B1); PG8_BAR;
            PG8_LDA(At, 0, 1); PG8_STAGE(PG8_SA(0, 0), a2, voffA);
            PG8_BAR; PG8_WAIT_L(0); PG8_MMA(1, 0, At, B0); PG8_BAR; PG8_SCHED;
            PG8_STAGE(PG8_SB(0, 1), b2 + hstep, voffB);
            PG8_WAIT_V(6); PG8_BAR; PG8_MMA(1, 1, At, B1); PG8_BAR;
            PG8_LDB(B0, 1, 0); PG8_SCHED; PG8_LDA(At, 1, 0); PG8_STAGE(PG8_SA(0, 1), a2 + hstep, voffA);
            PG8_WAIT_L(8); PG8_BAR; PG8_WAIT_L(0); PG8_MMA(0, 0, At, B0); PG8_BAR; PG8_SCHED;
            PG8_LDB(B1, 1, 1); PG8_STAGE(PG8_SB(1, 0), b3, voffB);
            PG8_BAR; PG8_WAIT_L(0); PG8_MMA(0, 1, At, B1); PG8_BAR;
            PG8_LDA(At, 1, 1); PG8_STAGE(PG8_SA(1, 0), a3, voffA);
            PG8_BAR; PG8_WAIT_L(0); PG8_MMA(1, 0, At, B0); PG8_BAR; PG8_SCHED;
            PG8_STAGE(PG8_SB(1, 1), b3 + hstep, voffB);
            PG8_WAIT_V(6); PG8_BAR; PG8_MMA(1, 1, At, B1); PG8_BAR;
            }
        }
        if constexpr (ALIGN_EPI) { if (wr == 0) PG8_BAR; }
        if constexpr (!Epi::AFTER_DRAIN) { E(acc, cur, wr, wc, fr, fq); S.done(cur); }
        if (!has_next) break;
#pragma unroll
        for (int a = 0; a < 2; ++a)
#pragma unroll
            for (int b = 0; b < 2; ++b)
#pragma unroll
                for (int m = 0; m < 4; ++m)
#pragma unroll
                    for (int n = 0; n < 2; ++n) acc[a][b][m][n] = (f32x4){0.f, 0.f, 0.f, 0.f};
        cur = nxt; cA = nA; cB = nB; ++ui;
        if constexpr (ALIGN_EPI) { if (wr == 1) PG8_BAR; }
    }
    PG8_WAIT_V(0);
    if constexpr (!ALIGN_EPI) { if (wr == 0) PG8_BAR; }
    PG8_BAR;
    if constexpr (Epi::AFTER_DRAIN) { E.fused(acc, cur, wr, wc, fr, fq, lds, wid, lane); S.done(cur); }
#undef PG8_SA
#undef PG8_SB
#undef PG8_STAGE
#undef PG8_LDA
#undef PG8_LDB
#undef PG8_MMA
#undef PG8_WAIT_V
#undef PG8_WAIT_L
#undef PG8_BAR
#undef PG8_SCHED
}
}
#define XB_TMO      128
#define XB_XCNT(j)  (256  + 64 * (j))
#define XB_XSUB(j)  (1280 + 64 * (j))
#define XB_XGEN(j)  (2304 + 64 * (j))
#define XB_TOP      3328
#define XB_TOPGEN   3392
#define XCD_BAR_WORDS 3456
#define XB_SPIN_CAP (1u << 18)

__device__ __forceinline__ unsigned xb_ld(unsigned* p)              { return __hip_atomic_load(p, __ATOMIC_RELAXED, __HIP_MEMORY_SCOPE_AGENT); }
__device__ __forceinline__ unsigned xb_add(unsigned* p, unsigned v) { return __hip_atomic_fetch_add(p, v, __ATOMIC_RELAXED, __HIP_MEMORY_SCOPE_AGENT); }
__device__ __forceinline__ unsigned xb_xcc_id() { return (unsigned)__builtin_amdgcn_s_getreg((3 << 11) | 20) & 0xFu; }
#define XB_SPIN(cond, bar) do { unsigned _sp = 0; while (cond) { __builtin_amdgcn_s_sleep(1); \
    if ((++_sp & 255u) == 0u) { if (xb_ld(&(bar)[XB_TMO])) break; if (_sp > XB_SPIN_CAP) { atomicAdd(&(bar)[XB_TMO], 1u); break; } } } } while (0)

struct XcdBarrier {
    unsigned* bar; unsigned x;
    volatile LAS unsigned* st;
};

__device__ __forceinline__ XcdBarrier xcd_barrier_post(unsigned* bar, volatile LAS unsigned* st) {
    XcdBarrier b; b.bar = bar; b.x = xb_xcc_id(); b.st = st;
    if (threadIdx.x == 0) (void)xb_add(&bar[XB_XCNT(b.x)], 1u);
    return b;
}
__device__ __forceinline__ void xcd_barrier_complete(unsigned* bar, unsigned x, unsigned& nloc, unsigned& nx) {
    const unsigned G = gridDim.x * gridDim.y * gridDim.z;
    unsigned sum, cnt, mine, sp = 0u;
    for (;;) {
        sum = 0u; cnt = 0u; mine = 0u;
#pragma unroll
        for (unsigned j = 0; j < 16; ++j) { const unsigned c = xb_ld(&bar[XB_XCNT(j)]); sum += c; cnt += (c > 0u) ? 1u : 0u; mine = (j == x) ? c : mine; }
        if (sum == G) break;
        __builtin_amdgcn_s_sleep(1);
        if ((++sp & 255u) == 0u) { if (xb_ld(&bar[XB_TMO])) break; if (sp > XB_SPIN_CAP) { atomicAdd(&bar[XB_TMO], 1u); break; } }
    }
    nloc = mine > 0u ? mine : 1u; nx = cnt > 0u ? cnt : 1u;
}

__device__ __forceinline__ void xcd_barrier(const XcdBarrier& b) {
    asm volatile("s_waitcnt vmcnt(0)" ::: "memory");
    __syncthreads();
    if (threadIdx.x == 0) {
        unsigned* bar = b.bar;
        __builtin_amdgcn_s_waitcnt(0);
        unsigned nloc = b.st[0], nx = b.st[1];
        if (nloc == 0u) { xcd_barrier_complete(bar, b.x, nloc, nx); b.st[0] = nloc; b.st[1] = nx; }
        const unsigned old = xb_add(&bar[XB_XSUB(b.x)], 1u);
        const unsigned gen = old / nloc;
        if (old + 1u == (gen + 1u) * nloc) {
            __builtin_amdgcn_fence(__ATOMIC_RELEASE, "agent");
            asm volatile("s_waitcnt vmcnt(0)" ::: "memory");
            const unsigned og = xb_add(&bar[XB_TOP], 1u);
            const unsigned tg = og / nx;
            if (og + 1u == (tg + 1u) * nx) xb_add(&bar[XB_TOPGEN], 1u);
            else XB_SPIN(xb_ld(&bar[XB_TOPGEN]) == tg, bar);
            __builtin_amdgcn_fence(__ATOMIC_ACQUIRE, "agent");
            xb_add(&bar[XB_XGEN(b.x)], 1u);
            asm volatile("s_waitcnt vmcnt(0)" ::: "memory");
        } else {
            XB_SPIN(xb_ld(&bar[XB_XGEN(b.x)]) == gen, bar);
            __builtin_amdgcn_fence(__ATOMIC_ACQUIRE, "agent");
            asm volatile("s_waitcnt vmcnt(0)" ::: "memory");
        }
    }
    __syncthreads();
}
#ifndef PG8_SP2
#define PG8_SP2 true
#endif
#ifndef PG8_ALIGN
#define PG8_ALIGN true
#endif

__device__ __forceinline__ float* ws_f32(CP p, size_t off) { return (float*)(p.ws + off); }
__device__ __forceinline__ bf16* ws_bf(CP p, size_t off) { return (bf16*)(p.ws + off); }
__device__ __forceinline__ bf16* ws_wt(CP p, size_t eoff) { return (bf16*)(p.ws + WS_WT) + eoff; }

template <int MAP> __device__ __forceinline__ int dmap(int n) {
    if constexpr (MAP == 2) { if (n < 2048) return n; const int j = (n - 2048) & 1023, isg = (n >= 3072) ? 1 : 0; return 2048 + (j >> 7) * 256 + isg * 128 + (j & 127); }
    if constexpr (MAP == 1) { const int h = n >> 8, j = n & 255; return (j < 128) ? (h * 128 + j) : (2048 + h * 128 + j - 128); } else return n; }
template <int MAP = 0> __device__ __forceinline__ void tr_item(const float* W, int K, int N, bf16* WT, const float* gain, LAS float* scr, int item, int lane) {
    const int nblk = N / 64, kb = item / nblk, nb = item % nblk, q = lane & 15, r = lane >> 4, k0 = 64 * kb + 16 * r, n0 = 64 * nb + 4 * q;
    const float* src = W + (size_t)k0 * N + n0;
    f32x4 v[16];
#pragma unroll
    for (int i = 0; i < 16; ++i) v[i] = *(const f32x4*)(src + (size_t)i * N);
    if (gain) {
#pragma unroll
        for (int i = 0; i < 16; ++i) v[i] *= gain[k0 + i]; }
#pragma unroll
    for (int j = 0; j < 4; ++j) {
        u32x4 lo, hi;
        lo.x = pk2(v[0][j], v[1][j]); lo.y = pk2(v[2][j], v[3][j]); lo.z = pk2(v[4][j], v[5][j]); lo.w = pk2(v[6][j], v[7][j]);
        hi.x = pk2(v[8][j], v[9][j]); hi.y = pk2(v[10][j], v[11][j]); hi.z = pk2(v[12][j], v[13][j]); hi.w = pk2(v[14][j], v[15][j]);
        bf16* dst = WT + (size_t)dmap<MAP>(n0 + j) * K + k0;
        *(u32x4*)dst = lo; *(u32x4*)(dst + 8) = hi;
    }
}

__device__ __forceinline__ void ph_prologue(CP p, LAS unsigned char* lds) {
    const int tid = tidx(), lane = tid & 63, wave = tid >> 6;
    const int gw = blockIdx.x * 8 + wave, NGW = gridDim.x * 8;
    LAS float* cact = (LAS float*)lds;
    LAS float* scr = (LAS float*)(lds + 32768 + wave * 8448);
    for (int i = tid; i < NB * D; i += 512) { const float v = p.c[i]; cact[i] = v / (1.f + expf(-v)); }
    __syncthreads();
    float* modp = ws_f32(p, WS_MODP);
    for (int it = gw; it < DEPTH * 48 * 16; it += NGW) {
        const int l = it / (48 * 16), r = it % (48 * 16), jc = r / 16, kc = r % 16;
        const float* w = p.ada_w + ((size_t)l * D + kc * 128) * (6 * D) + jc * 256 + lane * 4;
        f32x4 a0 = {0.f, 0.f, 0.f, 0.f}, a1 = a0, a2 = a0, a3 = a0;
#pragma unroll 8
        for (int k = 0; k < 128; ++k) { const f32x4 wv = *(const f32x4*)(w + (size_t)k * (6 * D)); const int kk = kc * 128 + k;
            a0 += cact[kk] * wv; a1 += cact[D + kk] * wv; a2 += cact[2 * D + kk] * wv; a3 += cact[3 * D + kk] * wv; }
        float* o = modp + ((size_t)(kc * DEPTH + l) * NB) * (6 * D) + jc * 256 + lane * 4;
        *(f32x4*)(o) = a0; *(f32x4*)(o + 6 * D) = a1; *(f32x4*)(o + 12 * D) = a2; *(f32x4*)(o + 18 * D) = a3;
    }
    constexpr int I_ABIN = (D / 64) * (DABIN / 64), I_ABOUT = (D / 64) * (D / 64), I_MLAIN = (D / 64) * (DMLAIN / 64), I_UQ = (QR / 64) * (NH * QKD / 64),
                  I_UKV = (KVR / 64) * (4096 / 64), I_MLAOUT = I_ABOUT, I_W1 = (D / 64) * (DFF / 64), I_W2 = (DFF / 64) * (D / 64);
    constexpr int NITEMS = 2 * (I_ABIN + I_ABOUT + I_MLAIN + I_UQ + I_UKV + I_MLAOUT) + DEPTH * (I_W1 + I_W2);
    for (int it = gw; it < NITEMS; it += NGW) {
        int r = it;
        if (r < 2 * I_ABIN) { const int e = r / I_ABIN; tr_item<2>(p.ab_w_in + (size_t)e * D * DABIN, D, DABIN, ws_wt(p, WT_ABIN) + (size_t)e * DABIN * D, nullptr, scr, r % I_ABIN, lane); continue; } r -= 2 * I_ABIN;
        if (r < 2 * I_ABOUT) { const int e = r / I_ABOUT; tr_item(p.ab_w_out + (size_t)e * D * D, D, D, ws_wt(p, WT_ABOUT) + (size_t)e * D * D, nullptr, scr, r % I_ABOUT, lane); continue; } r -= 2 * I_ABOUT;
        if (r < 2 * I_MLAIN) { const int e = r / I_MLAIN; tr_item(p.mla_w_in + (size_t)e * D * DMLAIN, D, DMLAIN, ws_wt(p, WT_MLAIN) + (size_t)e * DMLAINP * D, nullptr, scr, r % I_MLAIN, lane); continue; } r -= 2 * I_MLAIN;
        if (r < 2 * I_UQ) { const int e = r / I_UQ; tr_item(p.mla_w_uq + (size_t)e * QR * NH * QKD, QR, NH * QKD, ws_wt(p, WT_UQ) + (size_t)e * NH * QKD * QR, p.mla_q_norm_g + (size_t)e * QR, scr, r % I_UQ, lane); continue; } r -= 2 * I_UQ;
        if (r < 2 * I_UKV) { const int e = r / I_UKV; tr_item<1>(p.mla_w_ukv + (size_t)e * KVR * 4096, KVR, 4096, ws_wt(p, WT_UKV) + (size_t)e * 4096 * KVR, p.mla_kv_norm_g + (size_t)e * KVR, scr, r % I_UKV, lane); continue; } r -= 2 * I_UKV;
        if (r < 2 * I_MLAOUT) { const int e = r / I_MLAOUT; tr_item(p.mla_w_out + (size_t)e * D * D, D, D, ws_wt(p, WT_MLAOUT) + (size_t)e * D * D, nullptr, scr, r % I_MLAOUT, lane); continue; } r -= 2 * I_MLAOUT;
        if (r < DEPTH * I_W1) { const int e = r / I_W1; tr_item(p.mlp_w1 + (size_t)e * D * DFF, D, DFF, ws_wt(p, WT_W1) + (size_t)e * DFF * D, nullptr, scr, r % I_W1, lane); continue; } r -= DEPTH * I_W1;
        { const int e = r / I_W2; tr_item(p.mlp_w2 + (size_t)e * DFF * D, DFF, D, ws_wt(p, WT_W2) + (size_t)e * D * DFF, nullptr, scr, r % I_W2, lane); }
    }
    {
        const int gt = blockIdx.x * 512 + tid, NT = gridDim.x * 512;
        constexpr int PADV = (DMLAINP - DMLAIN) * D / 8;
        for (int i = gt; i < 2 * PADV; i += NT) { const int e = i / PADV, r = i % PADV;
            *(u32x4*)(ws_wt(p, WT_MLAIN) + (size_t)e * DMLAINP * D + (size_t)DMLAIN * D + (size_t)r * 8) = (u32x4){0u, 0u, 0u, 0u}; }
        float* rope = ws_f32(p, WS_ROPE);
        for (int idx = gt; idx < SEQ * 32; idx += NT) {
            const int pos = idx >> 5, i = idx & 31;
            const double inv = exp(-(double)i * (9.210340371976184 / 32.0));
            const double a = (double)pos * inv;
            const double q = rint(a * 0.6366197723675814);
            double r = fma(-q, 1.5707963267948966, a); r = fma(-q, 6.123233995736766e-17, r);
            const double r2 = r * r;
            const double sn = r * (1.0 + r2 * (-1.0 / 6.0 + r2 * (1.0 / 120.0 + r2 * (-1.0 / 5040.0 + r2 * (1.0 / 362880.0 + r2 * (-1.0 / 39916800.0 + r2 * (1.0 / 6227020800.0)))))));
            const double cs = 1.0 + r2 * (-0.5 + r2 * (1.0 / 24.0 + r2 * (-1.0 / 720.0 + r2 * (1.0 / 40320.0 + r2 * (-1.0 / 3628800.0 + r2 * (1.0 / 479001600.0 + r2 * (-1.0 / 87178291200.0)))))));
            const int qi = ((int)q) & 3;
            const double s_ = (qi == 0) ? sn : (qi == 1) ? cs : (qi == 2) ? -sn : -cs;
            const double c_ = (qi == 0) ? cs : (qi == 1) ? -sn : (qi == 2) ? -cs : sn;
            rope[pos * 64 + i] = (float)c_; rope[pos * 64 + 32 + i] = (float)s_;
        }
    }
}

__device__ __forceinline__ void ph_modfin(CP p) {
    const int gt = blockIdx.x * 512 + tidx(), NT = gridDim.x * 512;
    const float* modp = ws_f32(p, WS_MODP); float* mod = ws_f32(p, WS_MOD);
    for (int i = gt; i < DEPTH * NB * 6 * D / 4; i += NT) {
        const int e = i * 4, j = e % (6 * D), lb = e / (6 * D), l = lb / NB;
        f32x4 a = *(const f32x4*)(p.ada_b + (size_t)l * 6 * D + j);
#pragma unroll
        for (int kc = 0; kc < 16; ++kc) a += *(const f32x4*)(modp + ((size_t)kc * DEPTH * NB + lb) * (6 * D) + j);
        *(f32x4*)(mod + (size_t)lb * 6 * D + j) = a;
    }
}

__device__ __forceinline__ void ph_norm(CP p, int l, int which, const float* xsrc, const bf16* xsb) {
    const int lane = tidx() & 63, gw = blockIdx.x * 8 + (tidx() >> 6), NGW = gridDim.x * 8;
    const float* g = (which ? p.norm2_g : p.norm1_g) + (size_t)l * D;
    const float* mod = ws_f32(p, WS_MOD) + (size_t)l * NB * 6 * D;
    bf16* H = ws_bf(p, WS_H);
    const int per = (M + NGW - 1) / NGW, r_lo = gw * per, r_hi = (r_lo + per < M) ? r_lo + per : M;
    int bcur = -1; f32x4 G[8], S[8];
    for (int row = r_lo; row < r_hi; ++row) {
        const int b = row / SEQ;
        if (b != bcur) { bcur = b; const float* sh = mod + (size_t)b * 6 * D + (which ? 3 : 0) * D; const float* sc = sh + D;
#pragma unroll
            for (int j = 0; j < 4; ++j)
#pragma unroll
                for (int q = 0; q < 2; ++q) { const int col = 8 * lane + 512 * j + 4 * q; G[2 * j + q] = *(const f32x4*)(g + col) * (1.0f + *(const f32x4*)(sc + col)); S[2 * j + q] = *(const f32x4*)(sh + col); } }
        f32x4 v[8]; float ss = 0.f;
        if (xsb) { const u32x4* xr = (const u32x4*)(xsb + (size_t)row * D) + lane;
#pragma unroll
            for (int j = 0; j < 4; ++j) { const u32x4 w = xr[64 * j]; v[2 * j] = (f32x4){bf_lo(w.x), bf_hi(w.x), bf_lo(w.y), bf_hi(w.y)}; v[2 * j + 1] = (f32x4){bf_lo(w.z), bf_hi(w.z), bf_lo(w.w), bf_hi(w.w)}; }
        } else { const f32x4* xr = (const f32x4*)(xsrc + (size_t)row * D) + 2 * lane;
#pragma unroll
            for (int j = 0; j < 4; ++j) { v[2 * j] = xr[128 * j]; v[2 * j + 1] = xr[128 * j + 1]; } }
#pragma unroll
        for (int j = 0; j < 8; ++j) ss += (v[j].x * v[j].x + v[j].y * v[j].y) + (v[j].z * v[j].z + v[j].w * v[j].w);
        const float r = 1.0f / sqrtf(wave_sum(ss) * (1.0f / D) + EPS);
        u32x4* o = (u32x4*)(H + (size_t)row * D) + lane;
#pragma unroll
        for (int j = 0; j < 4; ++j) { const f32x4 h0 = v[2 * j] * r * G[2 * j] + S[2 * j], h1 = v[2 * j + 1] * r * G[2 * j + 1] + S[2 * j + 1];
            o[64 * j] = (u32x4){pk2(h0.x, h0.y), pk2(h0.z, h0.w), pk2(h1.x, h1.y), pk2(h1.z, h1.w)}; }
    }
}

__device__ __forceinline__ void ph_even_post(CP p, int e) {
    const int lane = tidx() & 63, gw = blockIdx.x * 8 + (tidx() >> 6), NGW = gridDim.x * 8;
    const float* RAW = ws_f32(p, WS_RAW); bf16* U = ws_bf(p, WS_U); bf16* VN = ws_bf(p, WS_VN); bf16* Y = ws_bf(p, WS_Y);
    const float* gn = p.sgu_norm_g + (size_t)e * DA;
    for (int row = gw; row < M; row += NGW) {
        const float* r = RAW + (size_t)row * DABIN;
        for (int j = lane * 4; j < DA; j += 256) { const f32x4 u = *(const f32x4*)(r + j);
            *(u32x2*)(U + (size_t)row * DA + j) = (u32x2){pk2(gelu_tanh(u.x), gelu_tanh(u.y)), pk2(gelu_tanh(u.z), gelu_tanh(u.w))}; }
        for (int g = 0; g < NG; ++g) { const int j = g * GD + lane * 2; const f32x2 vv = *(const f32x2*)(r + DA + j);
            const float v0 = gelu_tanh(vv.x), v1 = gelu_tanh(vv.y);
            const float rr = 1.0f / sqrtf(wave_sum(v0 * v0 + v1 * v1) * (1.0f / GD) + EPS);
            *(unsigned*)(VN + (size_t)row * DA + j) = pk2(v0 * rr * gn[j], v1 * rr * gn[j + 1]); }
        for (int j = lane * 4; j < DA; j += 256) { const f32x4 a = *(const f32x4*)(r + 2 * DA + j), gg = *(const f32x4*)(r + 3 * DA + j);
            *(u32x2*)(Y + (size_t)row * DA + j) = (u32x2){pk2(a.x * sigmoidf_(gg.x), a.y * sigmoidf_(gg.y)), pk2(a.z * sigmoidf_(gg.z), a.w * sigmoidf_(gg.w))}; }
    }
}

__device__ __forceinline__ void ph_sgu_naive(CP p, int e, LAS unsigned char* lds) {
    const int tid = tidx();
    LAS float* vl = (LAS float*)lds; LAS float* wl = (LAS float*)(lds + 65536);
    const bf16* U = ws_bf(p, WS_U); const bf16* VN = ws_bf(p, WS_VN); bf16* AB = ws_bf(p, WS_AB);
    for (int unit = blockIdx.x; unit < NB * (SEQ / 128) * NG; unit += gridDim.x) {
        const int g = unit % NG, row0 = (unit / NG) * 128;
        const float* w = p.sgu_w + ((size_t)e * NG + g) * 128 * 128; const float* bs = p.sgu_b + ((size_t)e * NG + g) * 128;
        for (int i = tid; i < 128 * 128; i += 512) { const int s = i >> 7, d = i & 127; vl[i] = bf2f(VN[(size_t)(row0 + s) * DA + g * GD + d]);
            const int t = i >> 7, ss = i & 127; wl[i] = (ss <= t) ? w[i] : 0.f; }
        __syncthreads();
        const int d = tid & 127, tq = tid >> 7;
        for (int i = 0; i < 32; ++i) { const int t = tq + 4 * i; float acc = 0.f;
            for (int s = 0; s <= t; ++s) acc += wl[t * 128 + s] * vl[s * 128 + d];
            const float mixed = acc + bs[t];
            const size_t ro = (size_t)(row0 + t);
            AB[ro * D + g * GD + d] = (bf16)f2bf(bf2f(U[ro * DA + g * GD + d]) * mixed); }
        __syncthreads();
    }
}

__device__ __forceinline__ void ph_conv_naive(CP p, int e) {
    const int gt = blockIdx.x * 512 + tidx(), NT = gridDim.x * 512;
    const bf16* Y = ws_bf(p, WS_Y); float* Z = ws_f32(p, WS_Z);
    const float* cw = p.conv_w + (size_t)e * CONVW * DA; const float* cb = p.conv_b + (size_t)e * DA;
    for (int idx = gt; idx < M * (DA / 2); idx += NT) {
        const int row = idx / (DA / 2), ch = (idx % (DA / 2)) * 2, t = row % SEQ;
        float a0 = cb[ch], a1 = cb[ch + 1];
        for (int j = 0; j < CONVW; ++j) { const int tt = t - (CONVW - 1) + j;
            if (tt >= 0) { const unsigned y = *(const unsigned*)(Y + (size_t)(row - (CONVW - 1) + j) * DA + ch);
                a0 += cw[j * DA + ch] * bf_lo(y); a1 += cw[j * DA + ch + 1] * bf_hi(y); } }
        *(f32x2*)(Z + (size_t)row * DA + ch) = (f32x2){a0, a1};
    }
}
__device__ __forceinline__ void ph_convln(CP p, int e) {
    const int lane = tidx() & 63, gw = blockIdx.x * 8 + (tidx() >> 6), NGW = gridDim.x * 8;
    const bf16* Z = ws_bf(p, WS_Z); bf16* AB = ws_bf(p, WS_AB);
    const float* lg = p.conv_ln_g + (size_t)e * DA; const float* lb = p.conv_ln_b + (size_t)e * DA;
    f32x4 Gv[4], Bv[4];
#pragma unroll
    for (int j = 0; j < 2; ++j)
#pragma unroll
        for (int q = 0; q < 2; ++q) { const int col = 8 * lane + 512 * j + 4 * q; Gv[2 * j + q] = *(const f32x4*)(lg + col); Bv[2 * j + q] = *(const f32x4*)(lb + col); }
    const int per = (M + NGW - 1) / NGW, r_lo = gw * per, r_hi = (r_lo + per < M) ? r_lo + per : M;
    for (int row = r_lo; row < r_hi; ++row) {
        const u32x4* zr = (const u32x4*)(Z + (size_t)row * DA) + lane; f32x4 v[4]; float s = 0.f;
#pragma unroll
        for (int j = 0; j < 2; ++j) { const u32x4 w = zr[64 * j]; v[2 * j] = (f32x4){bf_lo(w.x), bf_hi(w.x), bf_lo(w.y), bf_hi(w.y)}; v[2 * j + 1] = (f32x4){bf_lo(w.z), bf_hi(w.z), bf_lo(w.w), bf_hi(w.w)}; }
#pragma unroll
        for (int j = 0; j < 4; ++j) s += (v[j].x + v[j].y) + (v[j].z + v[j].w);
        const float mean = wave_sum(s) * (1.0f / DA); float q = 0.f;
#pragma unroll
        for (int j = 0; j < 4; ++j) { v[j] = v[j] - mean; q += (v[j].x * v[j].x + v[j].y * v[j].y) + (v[j].z * v[j].z + v[j].w * v[j].w); }
        const float rstd = 1.0f / sqrtf(wave_sum(q) * (1.0f / DA) + EPS);
        u32x4* o = (u32x4*)(AB + (size_t)row * D + DA) + lane;
#pragma unroll
        for (int j = 0; j < 2; ++j) { u32x4 w;
#pragma unroll
            for (int qq = 0; qq < 2; ++qq) { f32x4 y = v[2 * j + qq] * rstd * Gv[2 * j + qq] + Bv[2 * j + qq]; y.x *= sigmoidf_(y.x); y.y *= sigmoidf_(y.y); y.z *= sigmoidf_(y.z); y.w *= sigmoidf_(y.w);
                if (qq == 0) { w.x = pk2(y.x, y.y); w.y = pk2(y.z, y.w); } else { w.z = pk2(y.x, y.y); w.w = pk2(y.z, y.w); } }
            o[64 * j] = w; }
    }
}

__device__ __forceinline__ void ph_mla_mid(CP p, int o) {
    const int lane = tidx() & 63, gw = blockIdx.x * 8 + (tidx() >> 6), NGW = gridDim.x * 8;
    bf16* CQ = ws_bf(p, WS_CQ); bf16* CKV = ws_bf(p, WS_CKV);
    const float* gq = p.mla_q_norm_g + (size_t)o * QR + lane * 8; const float* gkv = p.mla_kv_norm_g + (size_t)o * KVR + lane * 8;
    const f32x4 gq0 = *(const f32x4*)gq, gq1 = *(const f32x4*)(gq + 4), gk0 = *(const f32x4*)gkv, gk1 = *(const f32x4*)(gkv + 4);
    const int per = (M + NGW - 1) / NGW, r_lo = gw * per, r_hi = (r_lo + per < M) ? r_lo + per : M;
    for (int row = r_lo; row < r_hi; ++row) {
#pragma unroll
        for (int part = 0; part < 2; ++part) {
            bf16* ptr = (part ? CKV : CQ) + (size_t)row * QR + lane * 8;
            const u32x4 v = *(const u32x4*)ptr;
            float f[8] = {bf_lo(v.x), bf_hi(v.x), bf_lo(v.y), bf_hi(v.y), bf_lo(v.z), bf_hi(v.z), bf_lo(v.w), bf_hi(v.w)};
            float ss = 0.f;
#pragma unroll
            for (int j = 0; j < 8; ++j) ss += f[j] * f[j];
            const float rr = 1.0f / sqrtf(wave_sum(ss) * (1.0f / QR) + EPS);
            const f32x4 g0 = part ? gk0 : gq0, g1 = part ? gk1 : gq1;
            u32x4 o4; o4.x = pk2(f[0] * rr * g0.x, f[1] * rr * g0.y); o4.y = pk2(f[2] * rr * g0.z, f[3] * rr * g0.w); o4.z = pk2(f[4] * rr * g1.x, f[5] * rr * g1.y); o4.w = pk2(f[6] * rr * g1.z, f[7] * rr * g1.w);
            *(u32x4*)ptr = o4;
        }
    }
}
__device__ __forceinline__ void ph_k_norm(CP p, int o) {
    const int lane = tidx() & 63, gw = blockIdx.x * 8 + (tidx() >> 6), NGW = gridDim.x * 8;
    bf16* KR = ws_bf(p, WS_KR); const float* rope = ws_f32(p, WS_ROPE);
    const float krg = (p.mla_k_head_g + (size_t)o * QKD)[NOPE + lane];
    const int per = (M + NGW - 1) / NGW, r_lo = gw * per, r_hi = (r_lo + per < M) ? r_lo + per : M;
    constexpr int NR = 8;
    for (int row = r_lo; row < r_hi; row += NR) {
        float kv[NR], cs[NR], sn[NR];
#pragma unroll
        for (int i = 0; i < NR; ++i) { const int rr = (row + i < r_hi) ? row + i : r_hi - 1, pos = rr % SEQ;
            kv[i] = bf2f(KR[(size_t)rr * ROPE + lane]); cs[i] = rope[pos * 64 + (lane & 31)]; sn[i] = rope[pos * 64 + 32 + (lane & 31)]; }
#pragma unroll
        for (int i = 0; i < NR; ++i) if (row + i < r_hi) {
            const float rrk = 1.0f / sqrtf(wave_sum(kv[i] * kv[i]) * (1.0f / ROPE) + EPS);
            const float vn = kv[i] * rrk * krg, partner = __shfl_xor(vn, 32);
            const float outv = (lane < 32) ? (vn * cs[i] - partner * sn[i]) : (partner * sn[i] + vn * cs[i]);
            KR[(size_t)(row + i) * ROPE + lane] = (bf16)f2bf(outv); }
    }
}
__device__ __forceinline__ void ph_attn_naive(CP p, LAS unsigned char* lds) {
    const int lane = tidx() & 63, wave = tidx() >> 6, gw = blockIdx.x * 8 + wave, NGW = gridDim.x * 8;
    const bf16* Q = ws_bf(p, WS_Q); const bf16* KN = ws_bf(p, WS_KN); const bf16* KR = ws_bf(p, WS_KR); const bf16* V = ws_bf(p, WS_V); bf16* O = ws_bf(p, WS_O);
    LAS float* ql = (LAS float*)lds + wave * 192;
    for (int idx = gw; idx < NB * NH * SEQ; idx += NGW) {
        const int bh = idx / SEQ, qq = idx % SEQ, q = (bh & 1) ? (SEQ - 1 - qq) : qq, b = bh / NH, h = bh % NH;
        const size_t rowq = (size_t)b * SEQ + q;
        const bf16* qp = Q + (rowq * NH + h) * QKD;
        ql[lane] = bf2f(qp[lane]); ql[64 + lane] = bf2f(qp[64 + lane]); ql[128 + lane] = bf2f(qp[128 + lane]);
        asm volatile("s_waitcnt lgkmcnt(0)" ::: "memory");
        float mrun = -1e30f, lrun = 0.f, o0 = 0.f, o1 = 0.f;
        for (int kc = 0; kc <= q; kc += 64) {
            const int key = kc + lane; const size_t rowk = (size_t)b * SEQ + key;
            float s = 0.f;
            const u32x4* kn = (const u32x4*)(KN + rowk * D + h * NOPE);
#pragma unroll 4
            for (int c = 0; c < 16; ++c) { const u32x4 w = kn[c]; const LAS float* qv = ql + c * 8;
                s += qv[0] * bf_lo(w.x) + qv[1] * bf_hi(w.x) + qv[2] * bf_lo(w.y) + qv[3] * bf_hi(w.y) + qv[4] * bf_lo(w.z) + qv[5] * bf_hi(w.z) + qv[6] * bf_lo(w.w) + qv[7] * bf_hi(w.w); }
            const u32x4* kr = (const u32x4*)(KR + rowk * ROPE);
#pragma unroll 4
            for (int c = 0; c < 8; ++c) { const u32x4 w = kr[c]; const LAS float* qv = ql + 128 + c * 8;
                s += qv[0] * bf_lo(w.x) + qv[1] * bf_hi(w.x) + qv[2] * bf_lo(w.y) + qv[3] * bf_hi(w.y) + qv[4] * bf_lo(w.z) + qv[5] * bf_hi(w.z) + qv[6] * bf_lo(w.w) + qv[7] * bf_hi(w.w); }
            if (key > q) s = -__builtin_inff();
            const float mnew = fmaxf(mrun, wave_max(s));
            const float pr = __builtin_amdgcn_exp2f(s - mnew), alpha = __builtin_amdgcn_exp2f(mrun - mnew);
            lrun = lrun * alpha + wave_sum(pr); o0 *= alpha; o1 *= alpha; mrun = mnew;
            const bf16* vp = V + ((size_t)b * SEQ + kc) * D + h * VD + lane * 2;
#pragma unroll 8
            for (int kk = 0; kk < 64; ++kk) { const float pk = __builtin_bit_cast(float, __builtin_amdgcn_readlane(__builtin_bit_cast(int, pr), kk));
                const unsigned w = *(const unsigned*)(vp + (size_t)kk * D); o0 += pk * bf_lo(w); o1 += pk * bf_hi(w); }
        }
        const float il = 1.0f / lrun;
        *(unsigned*)(O + rowq * D + h * VD + lane * 2) = pk2(o0 * il, o1 * il);
    }
}

typedef float f32x16 __attribute__((ext_vector_type(16)));
constexpr int AT_KPITCH = 400, AT_VPITCH = 144;
constexpr int AT_KBUF = 64 * AT_KPITCH, AT_VBUF = 128 * AT_VPITCH;
constexpr int AT_K0 = 0, AT_V0 = 2 * AT_KBUF;
#ifndef AT_PRIO_MODE
#define AT_PRIO_MODE 1
#endif
#if AT_PRIO_MODE == 1
#define AT_PRIO(x) __builtin_amdgcn_s_setprio(x)
#else
#define AT_PRIO(x) do {} while (0)
#endif
#ifndef AT_VDEPTH
#define AT_VDEPTH 3
#endif
#ifndef AT_KDEPTH
#define AT_KDEPTH 3
#endif
constexpr float AT_THR = 8.0f;

__device__ __forceinline__ float half_max(float x) {
    float a = x, b = x;
    asm volatile("s_nop 1\n\tv_permlane32_swap_b32 %0, %1" : "+v"(a), "+v"(b));
    return fmaxf(a, b); }
__device__ __forceinline__ float half_sum(float x) { return x + __shfl_xor(x, 32); }

template <bool FAST> __device__ __forceinline__ void attn_unit(const bf16* Q, const bf16* KN, const bf16* KR, const bf16* VT, bf16* O, const float* qhg_in, const float* rope_in, const float* msq_in, LAS unsigned char* lds, int b, int h, int qb, int tid) {
    const float* qhg = qhg_in; const float* rope = rope_in; const float* msq = msq_in; asm volatile("" : "+s"(qhg), "+s"(rope), "+s"(msq));
    int lane = tid & 63; asm volatile("" : "+v"(lane));
    const int w = __builtin_amdgcn_readfirstlane(tid >> 6), r32 = lane & 31, hi = lane >> 5;
    const size_t rowbase = (size_t)b * SEQ;
    const int qrow = 256 * qb + 32 * w + r32;
    bf16x8 qf[12];
    {
        const bf16* qp = Q + ((rowbase + qrow) * NH + h) * QKD + 8 * hi;
        float ssn = 0.f, ssr = 0.f;
#pragma unroll
        for (int kk = 0; kk < 12; ++kk) { qf[kk] = *(const bf16x8*)(qp + 16 * kk); const u32x4 v = __builtin_bit_cast(u32x4, qf[kk]);
            const float s8 = (bf_lo(v.x) * bf_lo(v.x) + bf_hi(v.x) * bf_hi(v.x)) + (bf_lo(v.y) * bf_lo(v.y) + bf_hi(v.y) * bf_hi(v.y)) + (bf_lo(v.z) * bf_lo(v.z) + bf_hi(v.z) * bf_hi(v.z)) + (bf_lo(v.w) * bf_lo(v.w) + bf_hi(v.w) * bf_hi(v.w));
            if (kk < 8) ssn += s8; else ssr += s8; }
        ssn = half_sum(ssn); ssr = half_sum(ssr);
        const f32x4 pa = *(const f32x4*)(msq + (rowbase + qrow) * 16), pb = *(const f32x4*)(msq + (rowbase + qrow) * 16 + 4);
        const float epsq = EPS * ((((pa[0] + pa[1]) + (pa[2] + pa[3])) + ((pb[0] + pb[1]) + (pb[2] + pb[3]))) * (1.0f / QR) + EPS);
        const float rn = QSCALE / sqrtf(ssn * (1.0f / NOPE) + epsq), rr = QSCALE / sqrtf(ssr * (1.0f / ROPE) + epsq);
#pragma unroll
        for (int kk = 0; kk < 8; ++kk) { const u32x4 v = __builtin_bit_cast(u32x4, qf[kk]);
            const u32x4 wq = {cvtpk(bf_lo(v.x) * rn, bf_hi(v.x) * rn), cvtpk(bf_lo(v.y) * rn, bf_hi(v.y) * rn), cvtpk(bf_lo(v.z) * rn, bf_hi(v.z) * rn), cvtpk(bf_lo(v.w) * rn, bf_hi(v.w) * rn)};
            qf[kk] = __builtin_bit_cast(bf16x8, wq); }
#pragma unroll
        for (int kk = 8; kk < 10; ++kk) {
            const int j0 = 16 * (kk - 8) + 8 * hi; const float* rp = rope + (size_t)qrow * 64 + j0; const float* gp = qhg + NOPE + j0;
            const u32x4 a = __builtin_bit_cast(u32x4, qf[kk]), bq = __builtin_bit_cast(u32x4, qf[kk + 2]);
            const f32x4 c0 = *(const f32x4*)rp, c1 = *(const f32x4*)(rp + 4), s0 = *(const f32x4*)(rp + 32), s1 = *(const f32x4*)(rp + 36);
            const f32x4 ga0 = *(const f32x4*)gp * rr, ga1 = *(const f32x4*)(gp + 4) * rr, gb0 = *(const f32x4*)(gp + 32) * rr, gb1 = *(const f32x4*)(gp + 36) * rr;
            const f32x4 x10 = (f32x4){bf_lo(a.x), bf_hi(a.x), bf_lo(a.y), bf_hi(a.y)} * ga0, x11 = (f32x4){bf_lo(a.z), bf_hi(a.z), bf_lo(a.w), bf_hi(a.w)} * ga1;
            const f32x4 x20 = (f32x4){bf_lo(bq.x), bf_hi(bq.x), bf_lo(bq.y), bf_hi(bq.y)} * gb0, x21 = (f32x4){bf_lo(bq.z), bf_hi(bq.z), bf_lo(bq.w), bf_hi(bq.w)} * gb1;
            const f32x4 o10 = x10 * c0 - x20 * s0, o11 = x11 * c1 - x21 * s1, o20 = x10 * s0 + x20 * c0, o21 = x11 * s1 + x21 * c1;
            const u32x4 w1 = {cvtpk(o10[0], o10[1]), cvtpk(o10[2], o10[3]), cvtpk(o11[0], o11[1]), cvtpk(o11[2], o11[3])}, w2 = {cvtpk(o20[0], o20[1]), cvtpk(o20[2], o20[3]), cvtpk(o21[0], o21[1]), cvtpk(o21[2], o21[3])};
            qf[kk] = __builtin_bit_cast(bf16x8, w1); qf[kk + 2] = __builtin_bit_cast(bf16x8, w2); }
    }
    f32x16 o[4];
#pragma unroll
    for (int d = 0; d < 4; ++d)
#pragma unroll
        for (int r = 0; r < 16; ++r) o[d][r] = 0.f;
    float m_run = -1e30f, l_run = 0.f;
    const int ntiles = 4 * (qb + 1), jdiag = 4 * qb + (w >> 1);
    const int kn_key = tid >> 4, kn_part = tid & 15;
    const int kr_key = tid >> 3, kr_part = tid & 7;
    const int vt_d = tid >> 3, vt_part = tid & 7;
    const bf16* gkn = KN + (rowbase + kn_key) * D + h * NOPE + kn_part * 8;
    const bf16* gkr = KR + (rowbase + kr_key) * ROPE + kr_part * 8;
    const bf16* gvt = VT + (size_t)(h * VD + vt_d) * M + rowbase + vt_part * 8;
    const int l_kn = kn_key * AT_KPITCH + kn_part * 16, l_kr = kr_key * AT_KPITCH + 256 + kr_part * 16, l_vt = vt_d * AT_VPITCH + (vt_part >> 1) * 32 + (vt_part & 1) * 8;
    u32x4 st0, st1, st2, st3, st4;
#define AT_LOAD(j) do { st0 = *(const u32x4*)(gkn + (size_t)(64 * (j)) * D); st1 = *(const u32x4*)(gkn + (size_t)(64 * (j) + 32) * D); st2 = *(const u32x4*)(gkr + (size_t)(64 * (j)) * ROPE); \
        st3 = *(const u32x4*)(gvt + 64 * (j)); st4 = *(const u32x4*)(gvt + (size_t)64 * M + 64 * (j)); } while (0)
#define AT_STORE(bf) do { LAS unsigned char* kb_ = lds + AT_K0 + (bf) * AT_KBUF; LAS unsigned char* vb_ = lds + AT_V0 + (bf) * AT_VBUF; \
        *(LAS u32x4*)(kb_ + l_kn) = st0; *(LAS u32x4*)(kb_ + l_kn + 32 * AT_KPITCH) = st1; *(LAS u32x4*)(kb_ + l_kr) = st2; \
        *(LAS u32x2*)(vb_ + l_vt) = (u32x2){st3.x, st3.y}; *(LAS u32x2*)(vb_ + l_vt + 16) = (u32x2){st3.z, st3.w}; \
        *(LAS u32x2*)(vb_ + l_vt + 64 * AT_VPITCH) = (u32x2){st4.x, st4.y}; *(LAS u32x2*)(vb_ + l_vt + 64 * AT_VPITCH + 16) = (u32x2){st4.z, st4.w}; } while (0)
    AT_LOAD(0); AT_STORE(0);
    __syncthreads();
    const int k_rd = r32 * AT_KPITCH + hi * 16;
    const int v_rd = r32 * AT_VPITCH + hi * 16;
    for (int j = 0; j < ntiles; ++j) {
        const int bf = j & 1;
        if (j + 1 < ntiles) AT_LOAD(j + 1);
        LAS unsigned char* vb_ = lds + AT_V0 + bf * AT_VBUF + v_rd; bf16x8 va[AT_VDEPTH], pf[4];
        if (j <= jdiag) {
            LAS unsigned char* kb_ = lds + AT_K0 + bf * AT_KBUF + k_rd;
            f32x16 s0, s1;
#pragma unroll
            for (int r = 0; r < 16; ++r) { s0[r] = 0.f; s1[r] = 0.f; }
            {
                bf16x8 ka[AT_KDEPTH][2];
#pragma unroll
                for (int q = 0; q < AT_KDEPTH; ++q) { ka[q][0] = *(const LAS bf16x8*)(kb_ + q * 32); ka[q][1] = *(const LAS bf16x8*)(kb_ + 32 * AT_KPITCH + q * 32); }
                __builtin_amdgcn_sched_barrier(0);
                AT_PRIO(1);
#pragma unroll
                for (int kk = 0; kk < 12; ++kk) { const int cur = kk % AT_KDEPTH;
                    s0 = __builtin_amdgcn_mfma_f32_32x32x16_bf16(ka[cur][0], qf[kk], s0, 0, 0, 0);
                    s1 = __builtin_amdgcn_mfma_f32_32x32x16_bf16(ka[cur][1], qf[kk], s1, 0, 0, 0);
                    if (kk + AT_KDEPTH < 12) { ka[cur][0] = *(const LAS bf16x8*)(kb_ + (kk + AT_KDEPTH) * 32); ka[cur][1] = *(const LAS bf16x8*)(kb_ + 32 * AT_KPITCH + (kk + AT_KDEPTH) * 32); }
                    __builtin_amdgcn_sched_barrier(0);
                }
            }
            AT_PRIO(0);
#pragma unroll
            for (int q = 0; q < AT_VDEPTH; ++q) va[q] = *(const LAS bf16x8*)(vb_ + (q & 3) * 32 * AT_VPITCH + (q >> 2) * 32);
            __builtin_amdgcn_sched_barrier(0);
            if (j == jdiag) {
                int dq = qrow - 64 * j - 4 * hi;
                asm volatile("" : "+v"(dq));
#pragma unroll
                for (int r = 0; r < 16; ++r) { const int c = (r & 3) + 8 * (r >> 2);
                    if (c > dq) s0[r] = -__builtin_inff();
                    if (c + 32 > dq) s1[r] = -__builtin_inff(); }
            }
            if constexpr (!FAST) {
            float mx = s0[0];
#pragma unroll
            for (int r = 1; r < 16; ++r) mx = fmaxf(mx, s0[r]);
#pragma unroll
            for (int r = 0; r < 16; ++r) mx = fmaxf(mx, s1[r]);
            mx = half_max(mx);
            if (!__all(mx - m_run <= AT_THR)) {
                const float mnew = fmaxf(m_run, mx), alpha = __builtin_amdgcn_exp2f(m_run - mnew);
                m_run = mnew; l_run *= alpha;
#pragma unroll
                for (int d = 0; d < 4; ++d)
#pragma unroll
                    for (int r = 0; r < 16; ++r) o[d][r] *= alpha;
            }
            }
#define AT_VFRAG(i) (*(const LAS bf16x8*)(vb_ + ((i) & 3) * 32 * AT_VPITCH + ((i) >> 2) * 32))
            float ps = 0.f;
#define AT_SQ(q, r) ((q) < 2 ? s0[8 * ((q) & 1) + (r)] : s1[8 * ((q) & 1) + (r)])
#define AT_PACKQ(q) do { const u32x4 pk_ = {cvtpk(AT_SQ(q, 0), AT_SQ(q, 1)), cvtpk(AT_SQ(q, 2), AT_SQ(q, 3)), cvtpk(AT_SQ(q, 4), AT_SQ(q, 5)), cvtpk(AT_SQ(q, 6), AT_SQ(q, 7))}; pf[q] = __builtin_bit_cast(bf16x8, pk_); } while (0)
#pragma unroll
            for (int r = 0; r < 8; ++r) { s0[r] = __builtin_amdgcn_exp2f(FAST ? s0[r] : s0[r] - m_run); ps += s0[r]; }
            AT_PACKQ(0);
            AT_PRIO(1);
            __builtin_amdgcn_sched_barrier(0);
#pragma unroll
            for (int q = 1; q < 4; ++q) {
#pragma unroll
                for (int d = 0; d < 4; ++d) { const int i = 4 * (q - 1) + d, cur = i % AT_VDEPTH;
                    o[d] = __builtin_amdgcn_mfma_f32_32x32x16_bf16(va[cur], pf[q - 1], o[d], 0, 0, 0);
                    va[cur] = AT_VFRAG(i + AT_VDEPTH);
                    if (q == 1) { s0[8 + 2 * d] = __builtin_amdgcn_exp2f(FAST ? s0[8 + 2 * d] : s0[8 + 2 * d] - m_run); s0[9 + 2 * d] = __builtin_amdgcn_exp2f(FAST ? s0[9 + 2 * d] : s0[9 + 2 * d] - m_run); ps += s0[8 + 2 * d] + s0[9 + 2 * d]; }
                    else { const int r0 = 8 * (q & 1) + 2 * d; s1[r0] = __builtin_amdgcn_exp2f(FAST ? s1[r0] : s1[r0] - m_run); s1[r0 + 1] = __builtin_amdgcn_exp2f(FAST ? s1[r0 + 1] : s1[r0 + 1] - m_run); ps += s1[r0] + s1[r0 + 1]; }
                    __builtin_amdgcn_sched_barrier(0);
                }
                if (q == 1) AT_PACKQ(1); else if (q == 2) AT_PACKQ(2); else AT_PACKQ(3);
                __builtin_amdgcn_sched_barrier(0);
            }
            l_run += ps;
#undef AT_SQ
#undef AT_PACKQ
        }
        if (j + 1 < ntiles) AT_STORE(bf ^ 1);
        if (j <= jdiag) {
            __builtin_amdgcn_sched_barrier(0);
#pragma unroll
            for (int i = 12; i < 16; ++i) { const int cur = i % AT_VDEPTH;
                o[i & 3] = __builtin_amdgcn_mfma_f32_32x32x16_bf16(va[cur], pf[i >> 2], o[i & 3], 0, 0, 0);
                if (i + AT_VDEPTH < 16) va[cur] = AT_VFRAG(i + AT_VDEPTH);
                __builtin_amdgcn_sched_barrier(0);
            }
            AT_PRIO(0);
        }
#undef AT_VFRAG
        __syncthreads();
    }
#undef AT_LOAD
#undef AT_STORE
    const float il = 1.0f / half_sum(l_run);
    bf16* op = O + (rowbase + qrow) * D + h * VD + 8 * hi;
#pragma unroll
    for (int d = 0; d < 4; ++d)
#pragma unroll
        for (int gp = 0; gp < 2; ++gp) {
            const u32x2 ev = {cvtpk(o[d][8 * gp + 0] * il, o[d][8 * gp + 1] * il), cvtpk(o[d][8 * gp + 2] * il, o[d][8 * gp + 3] * il)};
            const u32x2 od = {cvtpk(o[d][8 * gp + 4] * il, o[d][8 * gp + 5] * il), cvtpk(o[d][8 * gp + 6] * il, o[d][8 * gp + 7] * il)};
            const u32x2 snd = hi ? ev : od;
            const u32x2 rcv = {(unsigned)__shfl_xor((int)snd.x, 32), (unsigned)__shfl_xor((int)snd.y, 32)};
            const u32x4 wv = hi ? (u32x4){rcv.x, rcv.y, od.x, od.y} : (u32x4){ev.x, ev.y, rcv.x, rcv.y};
            *(u32x4*)(op + 32 * d + 16 * gp) = wv;
        }
}

__device__ __forceinline__ void ph_attn(CP p, int oidx, LAS unsigned char* lds) {
    const int tid = tidx(); const float* qhg = p.mla_q_head_g + (size_t)oidx * QKD; const float* rope = ws_f32(p, WS_ROPE); const float* msq = ws_f32(p, WS_MSQ);
    const int G = gridDim.x, bx = blockIdx.x, vcu = (G % 8 == 0) ? (bx % 8) * (G / 8) + bx / 8 : bx;
    const bf16* Q = ws_bf(p, WS_Q); const bf16* KN = ws_bf(p, WS_KN); const bf16* KR = ws_bf(p, WS_KR); const bf16* VT = ws_bf(p, WS_VT); bf16* O = ws_bf(p, WS_O);
    const float* khg = p.mla_k_head_g + (size_t)oidx * QKD; const int ln = tid & 63;
    const float g1 = wave_max(fmaxf(fabsf(khg[ln] * qhg[ln]), fabsf(khg[ln + 64] * qhg[ln + 64]))), g2q = wave_max(fabsf(qhg[NOPE + ln])), g2k = wave_max(fabsf(khg[NOPE + ln]));
    const float sbound = QSCALE * (128.f * g1 + 64.f * g2q * g2k);
    const bool fast = __builtin_amdgcn_readfirstlane((int)(sbound < 96.f)) != 0;
    for (int item = vcu; item < NB * NH * 8; item += G) {
        const int bh = item >> 3, s = item & 7, b = bh / NH, h = bh % NH;
        for (int u = 0; u < 2; ++u) { int qb = u ? s : 15 - s; asm volatile("" : "+s"(qb));
            if (fast) attn_unit<true>(Q, KN, KR, VT, O, qhg, rope, msq, lds, b, h, qb, tid); else attn_unit<false>(Q, KN, KR, VT, O, qhg, rope, msq, lds, b, h, qb, tid); }
    }
}

constexpr int SG_PITCH = 272;
__device__ __forceinline__ void ph_sgu(CP p, int e, LAS unsigned char* lds) {
    const int tid = tidx(), lane = tid & 63, w = __builtin_amdgcn_readfirstlane(tid >> 6), fr = lane & 15, fq = lane >> 4;
    LAS unsigned char* Wl = lds; LAS unsigned char* Vl = lds + 128 * SG_PITCH; LAS float* rl = (LAS float*)(lds + 2 * 128 * SG_PITCH);
    const bf16* Gb = ws_bf(p, WS_U); bf16* AB = ws_bf(p, WS_AB);
    const int G = gridDim.x;
    for (int unit = blockIdx.x; unit < NB * (SEQ / 128) * NG; unit += G) {
        const int g = unit % NG, row0 = (unit / NG) * 128;
        __syncthreads();
        {
            const int s = tid >> 2, d0 = (tid & 3) * 32; const bf16* vsrc = Gb + (size_t)(row0 + s) * D + DA + g * GD + d0; float ss = 0.f;
#pragma unroll
            for (int c = 0; c < 4; ++c) { const u32x4 v = *(const u32x4*)(vsrc + 8 * c); const unsigned vv[4] = {v.x, v.y, v.z, v.w};
#pragma unroll
                for (int j = 0; j < 4; ++j) { const float a = bf_lo(vv[j]), b = bf_hi(vv[j]); ss += a * a + b * b;
                    *(LAS bf16*)(Vl + (d0 + 8 * c + 2 * j) * SG_PITCH + s * 2) = (bf16)(vv[j] & 0xffffu); *(LAS bf16*)(Vl + (d0 + 8 * c + 2 * j + 1) * SG_PITCH + s * 2) = (bf16)(vv[j] >> 16); } }
            ss += __shfl_xor(ss, 1); ss += __shfl_xor(ss, 2);
            if ((tid & 3) == 0) rl[s] = 1.0f / sqrtf(ss * (1.0f / GD) + EPS);
        }
        __syncthreads();
        {
            const int t = tid >> 2, s0 = (tid & 3) * 32; const float* wsrc = p.sgu_w + (((size_t)e * NG + g) * 128 + t) * 128 + s0;
#pragma unroll
            for (int c = 0; c < 4; ++c) { const f32x4 a = *(const f32x4*)(wsrc + 8 * c), b = *(const f32x4*)(wsrc + 8 * c + 4); const int s = s0 + 8 * c;
                const f32x4 ra = *(const LAS f32x4*)(rl + s), rb = *(const LAS f32x4*)(rl + s + 4);
                u32x4 o; o.x = pk2(s + 0 <= t ? a.x * ra.x : 0.f, s + 1 <= t ? a.y * ra.y : 0.f); o.y = pk2(s + 2 <= t ? a.z * ra.z : 0.f, s + 3 <= t ? a.w * ra.w : 0.f);
                o.z = pk2(s + 4 <= t ? b.x * rb.x : 0.f, s + 5 <= t ? b.y * rb.y : 0.f); o.w = pk2(s + 6 <= t ? b.z * rb.z : 0.f, s + 7 <= t ? b.w * rb.w : 0.f);
                *(LAS u32x4*)(Wl + t * SG_PITCH + s * 2) = o; }
        }
        __syncthreads();
        f32x4 acc[8];
#pragma unroll
        for (int db = 0; db < 8; ++db) acc[db] = (f32x4){0.f, 0.f, 0.f, 0.f};
        const int nks = (16 * w + 15) / 32 + 1;
        for (int ks = 0; ks < nks; ++ks) {
            const bf16x8 wf = *(const LAS bf16x8*)(Wl + (16 * w + fr) * SG_PITCH + (32 * ks + 8 * fq) * 2);
#pragma unroll
            for (int db = 0; db < 8; ++db) { const bf16x8 vf = *(const LAS bf16x8*)(Vl + (16 * db + fr) * SG_PITCH + (32 * ks + 8 * fq) * 2);
                acc[db] = __builtin_amdgcn_mfma_f32_16x16x32_bf16(vf, wf, acc[db], 0, 0, 0); }
        }
        const int t = 16 * w + fr; const float bs = p.sgu_b[((size_t)e * NG + g) * 128 + t];
        const float* gn = p.sgu_norm_g + (size_t)e * DA + g * GD;
        const size_t ro = (size_t)(row0 + t);
#pragma unroll
        for (int pq = 0; pq < 4; ++pq) {
            const f32x4 gg0 = *(const f32x4*)(gn + 32 * pq + 4 * fq), gg1 = *(const f32x4*)(gn + 32 * pq + 16 + 4 * fq);
            const f32x4 m0 = gg0 * acc[2 * pq] + bs, m1 = gg1 * acc[2 * pq + 1] + bs;
            const bool odd = (fq & 1) != 0; const f32x4 snd = odd ? m0 : m1; f32x4 rcv;
#pragma unroll
            for (int i = 0; i < 4; ++i) rcv[i] = __shfl_xor(snd[i], 16);
            const f32x4 lo = odd ? rcv : m0, hi4 = odd ? m1 : rcv;
            const int d = 16 * (2 * pq + (odd ? 1 : 0)) + 4 * (fq & 2);
            const u32x4 u = *(const u32x4*)(Gb + ro * D + g * GD + d);
            const u32x4 o = {pk2(bf_lo(u.x) * lo[0], bf_hi(u.x) * lo[1]), pk2(bf_lo(u.y) * lo[2], bf_hi(u.y) * lo[3]), pk2(bf_lo(u.z) * hi4[0], bf_hi(u.z) * hi4[1]), pk2(bf_lo(u.w) * hi4[2], bf_hi(u.w) * hi4[3])};
            *(u32x4*)(AB + ro * D + g * GD + d) = o; }
    }
}

__device__ __forceinline__ void ph_conv(CP p, int e, LAS unsigned char* lds) {
    const int tid = tidx(), lane = tid & 63, wvi = tid >> 6;
    const bf16* Y = ws_bf(p, WS_Y); bf16* AB = ws_bf(p, WS_AB);
    const float* cw = p.conv_w + (size_t)e * CONVW * DA + 2 * tid; const f32x2 cb = *(const f32x2*)(p.conv_b + (size_t)e * DA + 2 * tid);
    f32x2 wv[CONVW];
#pragma unroll
    for (int j = 0; j < CONVW; ++j) wv[j] = *(const f32x2*)(cw + (size_t)j * DA);
    const float* lg = p.conv_ln_g + (size_t)e * DA; const float* lb = p.conv_ln_b + (size_t)e * DA;
    f32x4 Gv[4], Bv[4];
#pragma unroll
    for (int j = 0; j < 2; ++j)
#pragma unroll
        for (int q = 0; q < 2; ++q) { const int col = 8 * lane + 512 * j + 4 * q; Gv[2 * j + q] = *(const f32x4*)(lg + col); Bv[2 * j + q] = *(const f32x4*)(lb + col); }
    LAS unsigned char* zbuf = lds + 62 * 2048;
    static_assert(62 * 2048 + 8 * 2048 <= LDS_MISC, "conv output block fits below the barrier words");
    for (int unit = blockIdx.x; unit < M / 32; unit += gridDim.x) {
        const int row0 = unit * 32, t0 = row0 % SEQ;
        __syncthreads();
        for (int c = tid; c < 62 * 128; c += 512) { const int i = c >> 7, part = c & 127; const int tt = t0 - 30 + i;
            u32x4 v = {0u, 0u, 0u, 0u}; if (tt >= 0) v = *(const u32x4*)(Y + (size_t)(row0 - 30 + i) * DA + part * 8);
            *(LAS u32x4*)(lds + i * 2048 + part * 16) = v; }
        __syncthreads();
#pragma unroll 1
        for (int ob = 0; ob < 4; ++ob) {
            unsigned zo[8];
            {   f32x2 win[38];
#pragma unroll
                for (int i = 0; i < 38; ++i) { const unsigned y = *(const LAS unsigned*)(lds + (8 * ob + i) * 2048 + tid * 4); win[i] = (f32x2){bf_lo(y), bf_hi(y)}; }
#pragma unroll
                for (int o = 0; o < 8; ++o) { f32x2 a = cb;
#pragma unroll
                    for (int j = 0; j < CONVW; ++j) a += wv[j] * win[o + j];
                    zo[o] = pk2(a.x, a.y); } }
            __syncthreads();
#pragma unroll
            for (int o = 0; o < 8; ++o) *(LAS unsigned*)(zbuf + o * 2048 + tid * 4) = zo[o];
            __syncthreads();
            {
                const LAS u32x4* zr = (const LAS u32x4*)(zbuf + wvi * 2048) + lane; f32x4 v[4]; float s = 0.f;
#pragma unroll
                for (int j = 0; j < 2; ++j) { const u32x4 w = zr[64 * j]; v[2 * j] = (f32x4){bf_lo(w.x), bf_hi(w.x), bf_lo(w.y), bf_hi(w.y)}; v[2 * j + 1] = (f32x4){bf_lo(w.z), bf_hi(w.z), bf_lo(w.w), bf_hi(w.w)}; }
#pragma unroll
                for (int j = 0; j < 4; ++j) s += (v[j].x + v[j].y) + (v[j].z + v[j].w);
                const float mean = wave_sum(s) * (1.0f / DA); float q = 0.f;
#pragma unroll
                for (int j = 0; j < 4; ++j) { v[j] = v[j] - mean; q += (v[j].x * v[j].x + v[j].y * v[j].y) + (v[j].z * v[j].z + v[j].w * v[j].w); }
                const float rstd = 1.0f / sqrtf(wave_sum(q) * (1.0f / DA) + EPS);
                u32x4* o = (u32x4*)(AB + (size_t)(row0 + 8 * ob + wvi) * D + DA) + lane;
#pragma unroll
                for (int j = 0; j < 2; ++j) { u32x4 w;
#pragma unroll
                    for (int qq = 0; qq < 2; ++qq) { f32x4 y = v[2 * j + qq] * rstd * Gv[2 * j + qq] + Bv[2 * j + qq]; y.x *= sigmoidf_(y.x); y.y *= sigmoidf_(y.y); y.z *= sigmoidf_(y.z); y.w *= sigmoidf_(y.w);
                        if (qq == 0) { w.x = pk2(y.x, y.y); w.y = pk2(y.z, y.w); } else { w.z = pk2(y.x, y.y); w.w = pk2(y.z, y.w); } }
                    o[64 * j] = w; }
            }
        }
    }
}

#ifndef GEMM_REPS
#define GEMM_REPS 1
#endif
#ifndef WGM_DEF
#define WGM_DEF 4
#endif
#ifndef WGM_W1
#define WGM_W1 WGM_DEF
#endif
#ifndef WGM_W2
#define WGM_W2 8
#endif
#ifndef WGM_N2K
#define WGM_N2K WGM_DEF
#endif
#ifndef WGM_ABIN
#define WGM_ABIN 2
#endif
template <class Epi> __device__ __forceinline__ void run_gemm(LAS unsigned char* lds, const bf16* A, const bf16* Bt, int Mr, int N, int K, const Epi& E0, float* scratch = nullptr, int wgm = WGM_DEF) {
    pg8::Gemm g{A, Bt, Mr, N, K}; pg8::StaticOrder S; S.init(Mr, N, (int)gridDim.x, (int)blockIdx.x, wgm);
    Epi E = E0;
    if (scratch) E.redirect(scratch);
    pg8::gemm_phase<Epi, pg8::StaticOrder, PG8_ALIGN, PG8_SP2>(lds, g, S, E);
}

struct SubsetOrder : pg8::StaticOrder {
    bool active;
    __device__ void init2(int Mr, int N, int first, int count) { const int c = (int)blockIdx.x - first; active = (c >= 0 && c < count); init(Mr, N, count, active ? c : 0); }
    __device__ bool next(int i, pg8::Unit& u) const { return active && pg8::StaticOrder::next(i, u); }
};
template <class Epi> __device__ __forceinline__ void run_gemm_sub(LAS unsigned char* lds, const bf16* A, const bf16* Bt, int Mr, int N, int K, const Epi& E, int first, int count) {
    pg8::Gemm g{A, Bt, Mr, N, K}; SubsetOrder S; S.init2(Mr, N, first, count);
    pg8::gemm_phase<Epi, SubsetOrder, PG8_ALIGN, PG8_SP2>(lds, g, S, E);
}
constexpr int MLP_SPLIT = 2;
enum Phase { PH_PRO = 0, PH_MODFIN, PH_NORM1, PH_NORM2, PH_G_ABIN, PH_EVEN_POST, PH_SGU_CONV, PH_CONVLN, PH_G_ABOUT, PH_G_MLAIN, PH_MLA_MID, PH_G_QKV, PH_K_NORM, PH_ATTN, PH_G_MLAOUT, PH_G_W1, PH_G_W2 };

template <int PH> __device__ __forceinline__ void run_phase(CP p, int l, LAS unsigned char* lds, int rep = 0, int half = 0) {
    const int e = l >> 1;
    const float* xcur = (l == 0) ? p.x : ws_f32(p, WS_X);
    const float* mod = ws_f32(p, WS_MOD) + (size_t)l * NB * 6 * D;
    if constexpr (PH == PH_PRO) ph_prologue(p, lds);
    if constexpr (PH == PH_MODFIN) ph_modfin(p);
    if constexpr (PH == PH_NORM1) ph_norm(p, l, 0, p.x, (l == 0) ? nullptr : ws_bf(p, WS_X));
    if constexpr (PH == PH_NORM2) ph_norm(p, l, 1, p.x, ws_bf(p, WS_X));
    if constexpr (PH == PH_G_ABIN) { pg8::EpiEvenIn E{ws_bf(p, WS_U), ws_bf(p, WS_Y)}; run_gemm(lds, ws_bf(p, WS_H), ws_wt(p, WT_ABIN) + (size_t)e * DABIN * D, M, DABIN, D, E, nullptr, WGM_ABIN); }
    if constexpr (PH == PH_EVEN_POST) ph_even_post(p, e);
    if constexpr (PH == PH_SGU_CONV) { ph_sgu(p, e, lds); ph_conv(p, e, lds); }
    if constexpr (PH == PH_CONVLN) ph_convln(p, e);
    if constexpr (PH == PH_G_ABOUT) {
        const bf16* A = ws_bf(p, WS_AB); const bf16* Bt = ws_wt(p, WT_ABOUT) + (size_t)e * D * D; float* scr = rep ? ws_f32(p, WS_RAW) : nullptr;
        if (l == 0) { pg8::EpiResidB<true, false> E{p.x, ws_bf(p, WS_X), mod + 2 * D, D, 6 * D, SEQ}; run_gemm(lds, A, Bt, M, D, D, E, scr, WGM_N2K); }
        else { pg8::EpiResidB<false, false> E{ws_bf(p, WS_X), ws_bf(p, WS_X), mod + 2 * D, D, 6 * D, SEQ}; run_gemm(lds, A, Bt, M, D, D, E, scr, WGM_N2K); } }
    if constexpr (PH == PH_G_MLAIN) { pg8::EpiBf16SplitSsq E{ws_bf(p, WS_CQ), QR, QR, (size_t)(WS_CKV - WS_CQ) / 2, ws_f32(p, WS_MSQ)}; run_gemm(lds, ws_bf(p, WS_H), ws_wt(p, WT_MLAIN) + (size_t)e * DMLAINP * D, M, 2 * QR, D, E); }
    if constexpr (PH == PH_MLA_MID) ph_mla_mid(p, e);
    if constexpr (PH == PH_G_QKV) {
        const int G = (int)gridDim.x, nkr = G / 4;
        { pg8::EpiFirst64 E{ws_bf(p, WS_KR)}; run_gemm_sub(lds, ws_bf(p, WS_H), ws_wt(p, WT_MLAIN) + (size_t)e * DMLAINP * D + (size_t)2 * QR * D, M, 256, D, E, 0, nkr); }
        { pg8::EpiBf16Plain E{ws_bf(p, WS_Q), NH * QKD}; run_gemm_sub(lds, ws_bf(p, WS_CQ), ws_wt(p, WT_UQ) + (size_t)e * NH * QKD * QR, M, NH * QKD, QR, E, nkr, G - nkr); }
        { pg8::EpiKNorm E{ws_bf(p, WS_KN), D, p.mla_k_head_g + (size_t)e * QKD, p.mla_q_head_g + (size_t)e * QKD, (LAS float*)(lds + LDS_SPARE), ws_f32(p, WS_MSQ)}; run_gemm(lds, ws_bf(p, WS_CKV), ws_wt(p, WT_UKV) + (size_t)e * 4096 * KVR, M, D, KVR, E); }
        { pg8::EpiVtScale E{ws_bf(p, WS_VT), M, ws_f32(p, WS_MSQ)}; run_gemm(lds, ws_wt(p, WT_UKV) + (size_t)e * 4096 * KVR + (size_t)2048 * KVR, ws_bf(p, WS_CKV), 2048, M, KVR, E); }
    }
    if constexpr (PH == PH_K_NORM) ph_k_norm(p, e);
    if constexpr (PH == PH_ATTN) ph_attn(p, e, lds);
    if constexpr (PH == PH_G_MLAOUT) { pg8::EpiResidB<false, false> E{ws_bf(p, WS_X), ws_bf(p, WS_X), mod + 2 * D, D, 6 * D, SEQ}; run_gemm(lds, ws_bf(p, WS_O), ws_wt(p, WT_MLAOUT) + (size_t)e * D * D, M, D, D, E, rep ? ws_f32(p, WS_RAW) : nullptr, WGM_N2K); }
    if constexpr (PH == PH_G_W1) { const size_t r0 = (size_t)half * (M / MLP_SPLIT);
        pg8::EpiRelu2 E{ws_bf(p, WS_HID) + r0 * DFF, DFF}; run_gemm(lds, ws_bf(p, WS_H) + r0 * D, ws_wt(p, WT_W1) + (size_t)l * DFF * D, M / MLP_SPLIT, DFF, D, E, nullptr, WGM_W1); }
    if constexpr (PH == PH_G_W2) { const size_t r0 = (size_t)half * (M / MLP_SPLIT);
        const bf16* A = ws_bf(p, WS_HID) + r0 * DFF; const bf16* Bt = ws_wt(p, WT_W2) + (size_t)l * D * DFF; const float* gt = mod + 5 * D + (size_t)(r0 / SEQ) * 6 * D; float* scr = rep ? ws_f32(p, WS_RAW) : nullptr;
        if (l == DEPTH - 1) { pg8::EpiResidB<false, true> E{ws_bf(p, WS_X) + r0 * D, p.out + r0 * D, gt, D, 6 * D, SEQ}; run_gemm(lds, A, Bt, M / MLP_SPLIT, D, DFF, E, scr, WGM_W2); }
        else { pg8::EpiResidB<false, false> E{ws_bf(p, WS_X) + r0 * D, ws_bf(p, WS_X) + r0 * D, gt, D, 6 * D, SEQ}; run_gemm(lds, A, Bt, M / MLP_SPLIT, D, DFF, E, scr, WGM_W2); } }
}

template <int PH> __global__ void __launch_bounds__(512, 2) k_phase(Params p, int l, int pad) {
    extern __shared__ __attribute__((aligned(16))) unsigned char lds_raw[];
    run_phase<PH>(*kparams(), l, (LAS unsigned char*)lds_raw);
}


__global__ void __launch_bounds__(512, 2) k_mega(Params p) {
    extern __shared__ __attribute__((aligned(16))) unsigned char lds_raw[];
    LAS unsigned char* lds = (LAS unsigned char*)lds_raw;
    volatile LAS unsigned* misc = (volatile LAS unsigned*)(lds + LDS_MISC);
    if (tidx() < 32) misc[tidx()] = 0u;
    __syncthreads();
    XcdBarrier bar = xcd_barrier_post((unsigned*)(kparams()->ws + WS_CTL) + CW_BAR, misc + 8);
#define GB() xcd_barrier(bar)
    run_phase<PH_PRO>(*kparams(), 0, lds); GB();
    run_phase<PH_MODFIN>(*kparams(), 0, lds); GB();
#pragma unroll
    for (int l = 0; l < DEPTH; ++l) {
        run_phase<PH_NORM1>(*kparams(), l, lds); GB();
        if ((l & 1) == 0) {
            run_phase<PH_G_ABIN>(*kparams(), l, lds); GB();
            run_phase<PH_SGU_CONV>(*kparams(), l, lds); GB();
            run_phase<PH_G_ABOUT>(*kparams(), l, lds); GB();
        } else {
            run_phase<PH_G_MLAIN>(*kparams(), l, lds); GB();
            run_phase<PH_G_QKV>(*kparams(), l, lds); GB();
            run_phase<PH_K_NORM>(*kparams(), l, lds); GB();
            run_phase<PH_ATTN>(*kparams(), l, lds); GB();
            run_phase<PH_G_MLAOUT>(*kparams(), l, lds); GB();
        }
        run_phase<PH_NORM2>(*kparams(), l, lds); GB();
        for (int hf = 0; hf < MLP_SPLIT; ++hf) {
            run_phase<PH_G_W1>(*kparams(), l, lds, 0, hf); GB();
            run_phase<PH_G_W2>(*kparams(), l, lds, 0, hf);
            if (hf == MLP_SPLIT - 1 && l != DEPTH - 1) GB();
        }
    }
#undef GB
}

template <int PH> static void launch_phase(const Params& p, int l, hipStream_t stream) {
    static bool attr_set = false;
    if (!attr_set) { (void)hipFuncSetAttribute((const void*)k_phase<PH>, hipFuncAttributeMaxDynamicSharedMemorySize, LDS_BYTES); attr_set = true; }
    hipLaunchKernelGGL(k_phase<PH>, dim3(256), dim3(512), LDS_BYTES, stream, p, l, 0);
}

extern "C" void kernel_launch(void* const* d_in, const int* in_sizes, int n_in, void* d_out, int out_size, void* d_ws, size_t ws_size, hipStream_t stream) {
    if (n_in != 25 || ws_size < WS_END) { fprintf(stderr, "kernel_launch: unexpected n_in %d / ws_size %zu (need %zu)\n", n_in, ws_size, (size_t)WS_END); return; }
    Params p; memset(&p, 0, sizeof(p));
    const float** pp = (const float**)&p;
    for (int i = 0; i < 25; ++i) pp[i] = (const float*)d_in[i];
    p.out = (float*)d_out; p.ws = (unsigned char*)d_ws;
    (void)hipMemsetAsync((char*)d_ws + WS_CTL + (size_t)CW_BAR * 4, 0, (size_t)XCD_BAR_WORDS * 4, stream);
#if MEGA
    static int grid = 0;
    if (!grid) {
        int dev = 0, cus = 0;
        (void)hipGetDevice(&dev); (void)hipDeviceGetAttribute(&cus, hipDeviceAttributeMultiprocessorCount, dev);
        (void)hipFuncSetAttribute((const void*)k_mega, hipFuncAttributeMaxDynamicSharedMemorySize, LDS_BYTES);
        grid = cus > 0 ? cus : 256;
    }
    hipLaunchKernelGGL(k_mega, dim3(grid), dim3(512), LDS_BYTES, stream, p);
#else
    launch_phase<PH_PRO>(p, 0, stream);
    launch_phase<PH_MODFIN>(p, 0, stream);
    for (int l = 0; l < DEPTH; ++l) {
        launch_phase<PH_NORM1>(p, l, stream);
        if ((l & 1) == 0) {
            launch_phase<PH_G_ABIN>(p, l, stream);
            launch_phase<PH_SGU_CONV>(p, l, stream);
            launch_phase<PH_G_ABOUT>(p, l, stream);
        } else {
            launch_phase<PH_G_MLAIN>(p, l, stream);
            launch_phase<PH_G_QKV>(p, l, stream);
            launch_phase<PH_K_NORM>(p, l, stream);
            launch_phase<PH_ATTN>(p, l, stream);
            launch_phase<PH_G_MLAOUT>(p, l, stream);
        }
        launch_phase<PH_NORM2>(p, l, stream);
        launch_phase<PH_G_W1>(p, l, stream);
        launch_phase<PH_G_W2>(p, l, stream);
    }
#endif
}
```
